# Optimizing an MI355X kernel written in HIP

```python
import functools
import jax, jax.numpy as jnp
from jax import lax
import numpy as np

D_MODEL = 2048
BATCH = 1
SEQ = 8192
DEPTH = 1
DEC_BATCH = 16
DEC_SEQ = 16
PAST_LEN = 2048

CHUNK = 64
N_META = 16
GLA_HEADS = 4
GLA_DK = D_MODEL // 2
GLA_DV = D_MODEL
HEAD_K = GLA_DK // GLA_HEADS
HEAD_V = GLA_DV // GLA_HEADS
GATE_RANK = 16
GATE_TEMP = 16.0
CONV_WIDTH = 3
CONV_DIM = D_MODEL
D_FF = -(-(8 * D_MODEL) // (3 * 256)) * 256
ALPHA = (2.0 * DEPTH) ** 0.25
BETA = (8.0 * DEPTH) ** -0.25
LN_EPS = 1e-5
RMS_EPS = 1e-6
IN_SIZES = (GLA_DK, GLA_DK, GLA_DV, GLA_DV, GATE_RANK, CONV_DIM, CONV_DIM, CONV_DIM, D_MODEL, D_MODEL)
D_IN_TOTAL = 2 * GLA_DK + 2 * GLA_DV + GATE_RANK + 3 * CONV_DIM + 2 * D_MODEL

kernel_name = "hybrid_gla_shortconv_streaming_step"


def _split_points(sizes):
    pts, acc = [], 0
    for s in sizes[:-1]:
        acc += s
        pts.append(acc)
    return pts


def layer_norm(x, g, b):
    xf = x.astype(jnp.float32)
    mu = jnp.mean(xf, axis=-1, keepdims=True)
    var = jnp.mean(jnp.square(xf - mu), axis=-1, keepdims=True)
    y = (xf - mu) * lax.rsqrt(var + LN_EPS)
    return (y * g.astype(jnp.float32) + b.astype(jnp.float32)).astype(x.dtype)


def to_heads(t, n_heads):
    B, L, W = t.shape
    return t.reshape(B, L, n_heads, W // n_heads).transpose(0, 2, 1, 3)


def from_heads(t):
    B, H, L, d = t.shape
    return t.transpose(0, 2, 1, 3).reshape(B, L, H * d)


def gla_chunk_step(S, q, k, v, g):
    S = S.astype(jnp.float32)
    qf, kf, vf = q.astype(jnp.float32), k.astype(jnp.float32), v.astype(jnp.float32)
    b = jnp.cumsum(g.astype(jnp.float32), axis=2)
    C = q.shape[2]
    causal = jnp.tril(jnp.ones((C, C), dtype=bool))
    diff = b[:, :, :, None, :] - b[:, :, None, :, :]
    decay = jnp.exp(jnp.where(causal[None, None, :, :, None], diff, -jnp.inf))
    scores = jnp.einsum('bhid,bhjd,bhijd->bhij', qf, kf, decay)
    o = jnp.einsum('bhij,bhjv->bhiv', scores, vf) + jnp.einsum('bhid,bhdv->bhiv', qf * jnp.exp(b), S)
    b_last = b[:, :, -1:, :]
    k_dec = kf * jnp.exp(b_last - b)
    S_new = jnp.exp(b_last[:, :, 0, :])[..., None] * S + jnp.einsum('bhjd,bhjv->bhdv', k_dec, vf)
    return S_new, o


def gla_prompt(q, k, v, g):
    B, H, L, _ = q.shape
    pad = (-L) % CHUNK
    padf = lambda t: jnp.pad(t, ((0, 0), (0, 0), (pad, 0), (0, 0)))
    n_blk = (L + pad) // CHUNK
    blk = lambda t: padf(t).reshape(B, H, n_blk, CHUNK, t.shape[-1]).transpose(2, 0, 1, 3, 4)
    S0 = jnp.zeros((B, H, HEAD_K, HEAD_V), jnp.float32)
    S_fin, o = lax.scan(lambda S, xs: gla_chunk_step(S, *xs), S0, (blk(q), blk(k), blk(v), blk(g)))
    o = o.transpose(1, 2, 0, 3, 4).reshape(B, H, n_blk * CHUNK, HEAD_V)[:, :, pad:]
    return o, S_fin


def gla_from_state(S0, q, k, v, g):
    S_new, o = gla_chunk_step(S0, q, k, v, g)
    return o, S_new


def short_conv(xc, buf, conv_w):
    L = xc.shape[1]
    xp = jnp.concatenate([buf.astype(xc.dtype), xc], axis=1)
    y = conv_w[0] * xp[:, 0:L]
    for i in range(1, CONV_WIDTH):
        y = y + conv_w[i] * xp[:, i:i + L]
    return y, xp[:, L:]


def trunk_layer(xn, gla_fn, conv_buf, w_in, w_gate_up, b_gate, gla_norm, conv_w, w_out,
                ln1_g, ln1_b, w_ffn_in, w_ffn_out, ln2_g, ln2_b):
    u = xn @ w_in
    q, k, v, r, a, cb, cc, cx, ga, gb = jnp.split(u, _split_points(IN_SIZES), axis=-1)
    g = jax.nn.log_sigmoid((a @ w_gate_up + b_gate).astype(jnp.float32)) / GATE_TEMP
    o, S_new = gla_fn(to_heads(q * (HEAD_K ** -0.5), GLA_HEADS), to_heads(k, GLA_HEADS),
                      to_heads(v, GLA_HEADS), to_heads(g, GLA_HEADS))
    o = o * lax.rsqrt(jnp.mean(o * o, axis=-1, keepdims=True) + RMS_EPS)
    o = from_heads(o) * gla_norm.astype(jnp.float32)
    y_a = (o * jax.nn.silu(r.astype(jnp.float32))).astype(xn.dtype)
    conv_y, conv_new = short_conv(cc * cx, conv_buf, conv_w)
    y_b = cb * conv_y
    m = jax.nn.sigmoid(ga) * y_a + jax.nn.sigmoid(gb) * y_b
    mix = m @ w_out
    h = layer_norm(ALPHA * xn + mix, ln1_g, ln1_b)
    gate, up = jnp.split(h @ w_ffn_in, [D_FF], axis=-1)
    f = (jax.nn.silu(gate) * up) @ w_ffn_out
    out = layer_norm(ALPHA * h + f, ln2_g, ln2_b)
    return out, S_new, conv_new


def setup_inputs(seed: int = 0) -> dict:
    key = jax.random.key(seed)
    ks = jax.random.split(key, 24)
    nrm = lambda k, shape, s: jax.random.normal(k, shape, jnp.float32) * s
    D = D_MODEL
    return {
        "x_prompt": nrm(ks[0], (BATCH, SEQ, D), 1.0),
        "x_sample": nrm(ks[1], (DEC_BATCH, DEC_SEQ, D), 1.0),
        "state_gla": nrm(ks[2], (DEPTH, DEC_BATCH, GLA_HEADS, HEAD_K, HEAD_V), 1.0),
        "cache_conv": nrm(ks[3], (DEPTH, DEC_BATCH, CONV_WIDTH - 1, D), 1.0),
        "meta_tokens": nrm(ks[4], (N_META, D), 1.0),
        "ln_in_g": 1.0 + nrm(ks[5], (D,), 0.02),
        "ln_in_b": nrm(ks[6], (D,), 0.02),
        "w_in": nrm(ks[7], (DEPTH, D, D_IN_TOTAL), D ** -0.5),
        "w_gate_up": nrm(ks[8], (DEPTH, GATE_RANK, GLA_DK), GATE_RANK ** -0.5),
        "b_gate": nrm(ks[9], (DEPTH, GLA_DK), 0.1),
        "gla_norm": 1.0 + nrm(ks[10], (DEPTH, GLA_DV), 0.02),
        "conv_w": nrm(ks[11], (DEPTH, CONV_WIDTH, CONV_DIM), CONV_WIDTH ** -0.5),
        "w_out": nrm(ks[12], (DEPTH, D, D), BETA * D ** -0.5),
        "ln1_g": 1.0 + nrm(ks[13], (DEPTH, D), 0.02),
        "ln1_b": nrm(ks[14], (DEPTH, D), 0.02),
        "w_ffn_in": nrm(ks[15], (DEPTH, D, 2 * D_FF), D ** -0.5),
        "w_ffn_out": nrm(ks[16], (DEPTH, D_FF, D), BETA * D_FF ** -0.5),
        "ln2_g": 1.0 + nrm(ks[17], (DEPTH, D), 0.02),
        "ln2_b": nrm(ks[18], (DEPTH, D), 0.02),
    }


def reference(x_prompt, x_sample, state_gla, cache_conv, meta_tokens, ln_in_g, ln_in_b,
              w_in, w_gate_up, b_gate, gla_norm, conv_w, w_out, ln1_g, ln1_b,
              w_ffn_in, w_ffn_out, ln2_g, ln2_b):
    B = x_prompt.shape[0]
    meta = jnp.broadcast_to(meta_tokens[None].astype(x_prompt.dtype), (B, N_META, D_MODEL))
    h_p = layer_norm(jnp.concatenate([meta, x_prompt], axis=1), ln_in_g, ln_in_b)
    h_s = layer_norm(x_sample, ln_in_g, ln_in_b)
    S_p_all, c_p_all, S_s_all, c_s_all = [], [], [], []
    for l in range(DEPTH):
        lw = (w_in[l], w_gate_up[l], b_gate[l], gla_norm[l], conv_w[l], w_out[l],
              ln1_g[l], ln1_b[l], w_ffn_in[l], w_ffn_out[l], ln2_g[l], ln2_b[l])
        zero_buf = jnp.zeros((B, CONV_WIDTH - 1, CONV_DIM), h_p.dtype)
        h_p, S_p, c_p = trunk_layer(h_p, gla_prompt, zero_buf, *lw)
        h_s, S_s, c_s = trunk_layer(h_s, functools.partial(gla_from_state, state_gla[l]), cache_conv[l], *lw)
        S_p_all.append(S_p.astype(x_prompt.dtype))
        c_p_all.append(c_p)
        S_s_all.append(S_s.astype(state_gla.dtype))
        c_s_all.append(c_s)
    y_prompt = h_p[:, N_META:]
    y_sample = h_s
    state_gla_prompt = jnp.stack(S_p_all, axis=0)
    cache_conv_prompt = jnp.stack(c_p_all, axis=0)
    state_gla_sample = jnp.stack(S_s_all, axis=0)
    cache_conv_sample = jnp.stack(c_s_all, axis=0)
    return (y_prompt, y_sample, state_gla_prompt, cache_conv_prompt, state_gla_sample, cache_conv_sample)
```

```cpp
#include <hip/hip_runtime.h>
#include <hip/hip_cooperative_groups.h>
#include <cstdio>
#include <cstdint>
namespace cg = cooperative_groups;

#define LAS __attribute__((address_space(3)))
typedef unsigned short bf16_t;
typedef short bf16x8 __attribute__((ext_vector_type(8)));
typedef float f32x4 __attribute__((ext_vector_type(4)));
typedef float f32x2 __attribute__((ext_vector_type(2)));
typedef unsigned u32x4 __attribute__((ext_vector_type(4)));
typedef unsigned u32x2 __attribute__((ext_vector_type(2)));
typedef __bf16 bf16x2n __attribute__((ext_vector_type(2)));

__device__ __forceinline__ unsigned pk2(float lo, float hi) { f32x2 v = {lo, hi}; bf16x2n r = __builtin_convertvector(v, bf16x2n); return __builtin_bit_cast(unsigned, r); }
__device__ __forceinline__ float bf2f(unsigned b) { return __uint_as_float(b << 16); }
__device__ __forceinline__ float bflo(unsigned w) { return __uint_as_float(w << 16); }
__device__ __forceinline__ float bfhi(unsigned w) { return __uint_as_float(w & 0xffff0000u); }
__device__ __forceinline__ float wave_sum(float v) {
#pragma unroll
    for (int o = 1; o < 64; o <<= 1) v += __shfl_xor(v, o);
    return v;
}
#define LDS_WAIT() asm volatile("s_waitcnt lgkmcnt(0)" ::: "memory")
__device__ __forceinline__ int fresh_tid() { int t = threadIdx.x; asm volatile("" : "+v"(t)); return t; }

constexpr int D = 2048, MP = 8704, DFF = 5632;
constexpr int N1 = 16640, N3 = 2 * DFF;
constexpr int ROW_META = 48, ROW_PROMPT = 64, ROW_SAMPLE = 8256, ROW_END = 8512;
constexpr int NSLOT = 145, NITEM = NSLOT * 4;
constexpr float ALPHA = 1.189207115002721f;
constexpr float LN_EPS = 1e-5f, RMS_EPS = 1e-6f;
constexpr size_t WS_BT1 = 0;
constexpr size_t WS_BT2 = WS_BT1 + (size_t)N1 * D * 2;
constexpr size_t WS_BT3 = WS_BT2 + (size_t)D * D * 2;
constexpr size_t WS_BT4 = WS_BT3 + (size_t)N3 * D * 2;
constexpr size_t WS_XN = WS_BT4 + (size_t)D * DFF * 2;
constexpr size_t WS_UQKV = WS_XN + (size_t)MP * D * 2;
constexpr size_t WS_UREST = WS_UQKV + (size_t)MP * 4096 * 2;
constexpr size_t WS_A = WS_UREST + (size_t)MP * 12288 * 2;
constexpr size_t WS_VT = WS_A + (size_t)MP * 16 * 4;
constexpr size_t WS_BAR = WS_VT + (size_t)NITEM * 512 * 64 * 2;
constexpr size_t WS_ZERO = WS_BAR + 15360;
constexpr size_t WS_END = WS_BAR + 16384;
constexpr size_t WS_QT = WS_BT1;
constexpr size_t WS_KD = WS_QT + (size_t)NITEM * 64 * 256 * 2;
constexpr size_t WS_PM = WS_KD + (size_t)NITEM * 256 * 64 * 2;
constexpr size_t WS_DL = WS_PM + (size_t)NITEM * 64 * 64 * 2;
constexpr size_t WS_O = WS_UQKV;
constexpr size_t WS_M = WS_VT;
constexpr size_t WS_T1 = WS_UQKV;
constexpr size_t WS_H = WS_UREST;
constexpr size_t WS_ACT = WS_UREST + (size_t)MP * D * 2;
constexpr size_t WS_T2 = WS_UQKV;
constexpr size_t WS_PART = WS_BT1;
static_assert((size_t)16 * 512 * D * 4 <= (size_t)N1 * D * 2, "partials must fit in Bt1");
static_assert(WS_DL + (size_t)NITEM * 256 * 4 <= WS_BT2, "prep buffers must fit in Bt1");
static_assert((size_t)MP * D * 2 <= (size_t)NITEM * 512 * 64 * 2, "m must fit in VT");
constexpr size_t OUT_YP = 0;
constexpr size_t OUT_YS = OUT_YP + (size_t)8192 * D;
constexpr size_t OUT_SP = OUT_YS + (size_t)256 * D;
constexpr size_t OUT_CP = OUT_SP + (size_t)4 * 256 * 512;
constexpr size_t OUT_SS = OUT_CP + (size_t)2 * D;
constexpr size_t OUT_CS = OUT_SS + (size_t)16 * 4 * 256 * 512;

struct Params { const float* in[19]; float* out; unsigned char* ws; };

namespace pg8 {
#define PG8_LAS __attribute__((address_space(3)))
constexpr int BM = 256, BK = 64, HALF = 128, HTB = HALF * BK * 2, STAGE_BYTES = 8 * HTB, NXCD = 8, WGM = 4;
__host__ __device__ __forceinline__ int lds_byte(int r, int c) { const int st = (r >> 4) * 2 + (c >> 5), rr = r & 15, cc = c & 31, ob = rr * 64 + cc * 2; return st * 1024 + (ob ^ (((ob >> 9) & 1) << 5)); }
__host__ __device__ __forceinline__ void stage_rc(int b, int& R, int& C) { const int st = b / 1024, sb = b % 1024, swz = sb ^ (((sb >> 9) & 1) << 5); R = (st >> 1) * 16 + swz / 64; C = (st & 1) * 32 + (swz % 64) / 2; }
__host__ __device__ __forceinline__ int perm32(int rho) { const int n = rho >> 4, i = rho & 15; return 8 * (i >> 2) + 4 * n + (i & 3); }
struct Unit { int pm, pn, kt0, nt, part; };
struct Gemm { const bf16_t* A; const bf16_t* Bt; int M, N, K; };
struct StaticOrder {
    int nM, nN, nwg, G, c, knt;
    __host__ __device__ void init(int M, int N, int K, int G_, int c_) { nM = M / BM; nN = N / BM; nwg = nM * nN; G = G_; c = c_; knt = K / BK; }
    __host__ __device__ bool next(int i, Unit& u) const {
        const long L = (long)i * G + c; if (L >= nwg) return false;
        int wgid = (int)L; { const int q = nwg / NXCD, r = nwg % NXCD, xcd = wgid % NXCD, off = wgid / NXCD; wgid = (xcd < r ? xcd * (q + 1) : r * (q + 1) + (xcd - r) * q) + off; }
        const int nig = WGM * nN, gid = wgid / nig, fm = gid * WGM, gsz = (nM - fm) < WGM ? (nM - fm) : WGM;
        u.pm = fm + ((wgid % nig) % gsz); u.pn = (wgid % nig) / gsz; u.kt0 = 0; u.nt = knt; u.part = -1; return true;
    }
    __device__ __forceinline__ void a_ready(const Unit&) const {}
    __device__ __forceinline__ void done(const Unit&) const {}
};

struct TailOrder {
    int c, knt, P, ntp;
    __host__ __device__ void init(int K, int c_, int P_, int ntp_) { c = c_; knt = K / BK; P = P_; ntp = ntp_; }
    __host__ __device__ bool next(int i, Unit& u) const {
        if (i == 0) { u.pm = (c & 7) * 4 + ((c >> 3) & 3); u.pn = c >> 5; u.kt0 = 0; u.nt = knt; u.part = -1; return true; }
        if (i == 1 && c < 16 * P) { const int lu = c / P, part = c - lu * P; u.pm = 32 + (lu >> 3); u.pn = lu & 7; u.kt0 = part * ntp; u.nt = (knt - u.kt0) < ntp ? (knt - u.kt0) : ntp; u.part = part; return true; }
        return false;
    }
    __device__ __forceinline__ void a_ready(const Unit&) const {}
    __device__ __forceinline__ void done(const Unit&) const {}
};

template <class Epi, class Sched, bool ALIGN_EPI = false, bool SP2 = false>
__device__ __forceinline__ void gemm_phase(PG8_LAS unsigned char* lds, const Gemm g, const Sched& S, const Epi& E) {
    const int tid = threadIdx.x, wid = __builtin_amdgcn_readfirstlane(tid >> 6), lane = tid & 63, wr = wid >> 2, wc = wid & 3, fr = lane & 15, fq = lane >> 4;
    const int K = g.K;
    unsigned voffA[2], voffB[2];
#pragma unroll
    for (int i = 0; i < 2; ++i) { int R, C; stage_rc(tid * 16 + i * 8192, R, C); const int Rb = Epi::PERM ? ((R & ~31) + perm32(R & 31)) : R;
        voffA[i] = (unsigned)(R * K + C) * 2u; voffB[i] = (unsigned)(Rb * K + C) * 2u; }
    const size_t kstep = (size_t)(BK * 2);
    const size_t hstep = (size_t)HALF * K * 2;
    const size_t tstep = 2 * hstep;
    const unsigned ldsw = (unsigned)wid * 1024u;
    const int aoff = lds_byte(wr * 64 + fr, fq * 8), boff = lds_byte(wc * 32 + fr, fq * 8);
#define PG8_SA(b, h) (((b) * 2 + (h)) * HTB)
#define PG8_SB(b, h) ((4 + (b) * 2 + (h)) * HTB)
#define PG8_STAGE(bufoff, gbase, voff) do { _Pragma("unroll") for (int _i = 0; _i < 2; ++_i) \
        __builtin_amdgcn_global_load_lds((const unsigned*)((const char*)(gbase) + (voff)[_i]), (PG8_LAS unsigned*)(lds + (bufoff) + ldsw + _i * 8192), 16, 0, 0); } while (0)
#define PG8_LDA(dst, b, h) do { _Pragma("unroll") for (int m = 0; m < 4; ++m) _Pragma("unroll") for (int k = 0; k < 2; ++k) dst[m][k] = *(const PG8_LAS bf16x8*)(lds + PG8_SA(b, h) + aoff + m * 2048 + k * 1024); } while (0)
#define PG8_LDB(dst, b, h) do { _Pragma("unroll") for (int n = 0; n < 2; ++n) _Pragma("unroll") for (int k = 0; k < 2; ++k) dst[n][k] = *(const PG8_LAS bf16x8*)(lds + PG8_SB(b, h) + boff + n * 2048 + k * 1024); } while (0)
#define PG8_MMA(ai, bj, At, Bt) do { __builtin_amdgcn_s_setprio(1); _Pragma("unroll") for (int m = 0; m < 4; ++m) _Pragma("unroll") for (int n = 0; n < 2; ++n) _Pragma("unroll") for (int k = 0; k < 2; ++k) \
        acc[ai][bj][m][n] = __builtin_amdgcn_mfma_f32_16x16x32_bf16(Bt[n][k], At[m][k], acc[ai][bj][m][n], 0, 0, 0); __builtin_amdgcn_s_setprio(0); } while (0)
#define PG8_WAIT_V(n) asm volatile("s_waitcnt vmcnt(" #n ")" ::: "memory")
#define PG8_WAIT_L(n) asm volatile("s_waitcnt lgkmcnt(" #n ")" ::: "memory")
#define PG8_BAR __builtin_amdgcn_s_barrier()
#define PG8_SCHED __builtin_amdgcn_sched_barrier(0)
    Unit cur, nxt; int ui = 0;
    if (!S.next(0, cur)) return;
    f32x4 acc[2][2][4][2];
#pragma unroll
    for (int a = 0; a < 2; ++a)
#pragma unroll
        for (int b = 0; b < 2; ++b)
#pragma unroll
            for (int m = 0; m < 4; ++m)
#pragma unroll
                for (int n = 0; n < 2; ++n) acc[a][b][m][n] = (f32x4){0.f, 0.f, 0.f, 0.f};
    bf16x8 At[4][2], B0[2][2], B1[2][2];
    const char* cA = (const char*)g.A + (size_t)cur.pm * tstep + (size_t)cur.kt0 * kstep; const char* cB = (const char*)g.Bt + (size_t)cur.pn * tstep + (size_t)cur.kt0 * kstep;
    S.a_ready(cur);
    if constexpr (SP2) {
        PG8_STAGE(PG8_SB(0, 0), cB, voffB); PG8_STAGE(PG8_SB(0, 1), cB + hstep, voffB); PG8_STAGE(PG8_SA(0, 0), cA, voffA); PG8_STAGE(PG8_SA(0, 1), cA + hstep, voffA);
        if (wr == 1) PG8_BAR;
        PG8_WAIT_V(2); PG8_BAR;
        PG8_STAGE(PG8_SB(1, 0), cB + kstep, voffB); PG8_STAGE(PG8_SA(1, 0), cA + kstep, voffA); PG8_STAGE(PG8_SB(1, 1), cB + hstep + kstep, voffB);
        PG8_WAIT_V(6); PG8_BAR;
    } else {
        PG8_STAGE(PG8_SB(0, 0), cB, voffB); PG8_STAGE(PG8_SA(0, 0), cA, voffA); PG8_STAGE(PG8_SB(0, 1), cB + hstep, voffB); PG8_STAGE(PG8_SA(0, 1), cA + hstep, voffA);
        if (wr == 1) PG8_BAR;
        PG8_WAIT_V(4); PG8_BAR;
        PG8_STAGE(PG8_SB(1, 0), cB + kstep, voffB); PG8_STAGE(PG8_SA(1, 0), cA + kstep, voffA); PG8_STAGE(PG8_SB(1, 1), cB + hstep + kstep, voffB);
        PG8_WAIT_V(6); PG8_BAR;
    }
    for (;;) {
        const bool has_next = S.next(ui + 1, nxt);
        const char* nA = has_next ? (const char*)g.A + (size_t)nxt.pm * tstep + (size_t)nxt.kt0 * kstep : cA; const char* nB = has_next ? (const char*)g.Bt + (size_t)nxt.pn * tstep + (size_t)nxt.kt0 * kstep : cB;
        const int nt = cur.nt;
        for (int t = 0; t < nt; t += 2) {
            const bool last = (t == nt - 2);
            const char* a1 = cA + (size_t)(t + 1) * kstep;
            const char* a2 = last ? nA : cA + (size_t)(t + 2) * kstep; const char* b2 = last ? nB : cB + (size_t)(t + 2) * kstep;
            const char* a3 = a2 + kstep; const char* b3 = b2 + kstep;
            if (last && has_next) S.a_ready(nxt);
            if constexpr (SP2) {
            PG8_LDB(B0, 0, 0); PG8_LDB(B1, 0, 1); PG8_SCHED; PG8_LDA(At, 0, 0); PG8_STAGE(PG8_SA(1, 1), a1 + hstep, voffA);
            PG8_WAIT_V(8); PG8_WAIT_L(0); PG8_BAR; PG8_MMA(0, 0, At, B0); PG8_MMA(0, 1, At, B1); PG8_BAR; PG8_SCHED;
            PG8_LDA(At, 0, 1); PG8_STAGE(PG8_SB(0, 0), b2, voffB); PG8_STAGE(PG8_SB(0, 1), b2 + hstep, voffB); PG8_STAGE(PG8_SA(0, 0), a2, voffA);
            PG8_WAIT_V(8); PG8_WAIT_L(0); PG8_BAR; PG8_MMA(1, 0, At, B0); PG8_MMA(1, 1, At, B1); PG8_BAR; PG8_SCHED;
            PG8_LDB(B0, 1, 0); PG8_LDB(B1, 1, 1); PG8_SCHED; PG8_LDA(At, 1, 0); PG8_STAGE(PG8_SA(0, 1), a2 + hstep, voffA);
            PG8_WAIT_V(8); PG8_WAIT_L(0); PG8_BAR; PG8_MMA(0, 0, At, B0); PG8_MMA(0, 1, At, B1); PG8_BAR; PG8_SCHED;
            PG8_LDA(At, 1, 1); PG8_STAGE(PG8_SB(1, 0), b3, voffB); PG8_STAGE(PG8_SB(1, 1), b3 + hstep, voffB); PG8_STAGE(PG8_SA(1, 0), a3, voffA);
            PG8_WAIT_V(8); PG8_WAIT_L(0); PG8_BAR; PG8_MMA(1, 0, At, B0); PG8_MMA(1, 1, At, B1); PG8_BAR; PG8_SCHED;
            } else {
            PG8_LDB(B0, 0, 0); PG8_SCHED; PG8_LDA(At, 0, 0); PG8_STAGE(PG8_SA(1, 1), a1 + hstep, voffA);
            PG8_WAIT_L(8); PG8_BAR; PG8_WAIT_L(0); PG8_MMA(0, 0, At, B0); PG8_BAR; PG8_SCHED;
            PG8_LDB(B1, 0, 1); PG8_STAGE(PG8_SB(0, 0), b2, voffB);
            PG8_BAR; PG8_WAIT_L(0); PG8_MMA(0, 1, At, B1); PG8_BAR;
            PG8_LDA(At, 0, 1); PG8_STAGE(PG8_SA(0, 0), a2, voffA);
            PG8_BAR; PG8_WAIT_L(0); PG8_MMA(1, 0, At, B0); PG8_BAR; PG8_SCHED;
            PG8_STAGE(PG8_SB(0, 1), b2 + hstep, voffB);
            PG8_WAIT_V(6); PG8_BAR; PG8_MMA(1, 1, At, B1); PG8_BAR;
            PG8_LDB(B0, 1, 0); PG8_SCHED; PG8_LDA(At, 1, 0); PG8_STAGE(PG8_SA(0, 1), a2 + hstep, voffA);
            PG8_WAIT_L(8); PG8_BAR; PG8_WAIT_L(0); PG8_MMA(0, 0, At, B0); PG8_BAR; PG8_SCHED;
            PG8_LDB(B1, 1, 1); PG8_STAGE(PG8_SB(1, 0), b3, voffB);
            PG8_BAR; PG8_WAIT_L(0); PG8_MMA(0, 1, At, B1); PG8_BAR;
            PG8_LDA(At, 1, 1); PG8_STAGE(PG8_SA(1, 0), a3, voffA);
            PG8_BAR; PG8_WAIT_L(0); PG8_MMA(1, 0, At, B0); PG8_BAR; PG8_SCHED;
            PG8_STAGE(PG8_SB(1, 1), b3 + hstep, voffB);
            PG8_WAIT_V(6); PG8_BAR; PG8_MMA(1, 1, At, B1); PG8_BAR;
            }
        }
        if constexpr (ALIGN_EPI) { if (wr == 0) PG8_BAR; }
        E(acc, cur, wr, wc, fr, fq);
        if (!has_next) break;
#pragma unroll
        for (int a = 0; a < 2; ++a)
#pragma unroll
            for (int b = 0; b < 2; ++b)
#pragma unroll
                for (int m = 0; m < 4; ++m)
#pragma unroll
                    for (int n = 0; n < 2; ++n) acc[a][b][m][n] = (f32x4){0.f, 0.f, 0.f, 0.f};
        cur = nxt; cA = nA; cB = nB; ++ui;
        if constexpr (ALIGN_EPI) { if (wr == 1) PG8_BAR; }
    }
    PG8_WAIT_V(0);
    if constexpr (!ALIGN_EPI) { if (wr == 0) PG8_BAR; }
    PG8_BAR;
#undef PG8_SA
#undef PG8_SB
#undef PG8_STAGE
#undef PG8_LDA
#undef PG8_LDB
#undef PG8_MMA
#undef PG8_WAIT_V
#undef PG8_WAIT_L
#undef PG8_BAR
#undef PG8_SCHED
}
}

struct EpiU {
    static constexpr bool PERM = true;
    bf16_t* Uqkv; bf16_t* Urest; float* Abuf;
    __device__ __forceinline__ void operator()(const f32x4 (&acc)[2][2][4][2], const pg8::Unit& u, int wr, int wc, int fr, int fq) const {
        const int row0 = u.pm * 256 + wr * 64 + fr;
        if (u.pn == 64) {
            if (wc == 0 && fq < 2) {
#pragma unroll
                for (int ai = 0; ai < 2; ++ai)
#pragma unroll
                    for (int m = 0; m < 4; ++m) { float* rp = Abuf + (size_t)(row0 + ai * 128 + m * 16) * 16 + 8 * fq;
                        *(f32x4*)(rp) = acc[ai][0][m][0]; *(f32x4*)(rp + 4) = acc[ai][0][m][1]; }
            }
        } else if (u.pn >= 16) {
            const int grp = (u.pn - 16) >> 4;
            const int col0 = grp * 2048 + ((u.pn - 16) & 15) * 128 + wc * 32 + 8 * fq;
#pragma unroll
            for (int ai = 0; ai < 2; ++ai)
#pragma unroll
                for (int m = 0; m < 4; ++m) { bf16_t* rp = Urest + (size_t)(row0 + ai * 128 + m * 16) * 6144 + col0;
                    float r[8];
#pragma unroll
                    for (int n = 0; n < 2; ++n)
#pragma unroll
                        for (int j = 0; j < 4; ++j) { const float a0 = acc[ai][0][m][n][j], a1 = acc[ai][1][m][n][j];
                            float v = a0 * a1;
                            if (grp != 1) { v = a0 * __builtin_amdgcn_rcpf(1.f + __expf(-a1)); if (grp == 0) v *= __builtin_amdgcn_rcpf(1.f + __expf(-a0)); }
                            r[n * 4 + j] = v; }
                    u32x4 o; o.x = pk2(r[0], r[1]); o.y = pk2(r[2], r[3]); o.z = pk2(r[4], r[5]); o.w = pk2(r[6], r[7]);
                    __builtin_nontemporal_store(o, (u32x4*)rp); }
        } else {
            const int col0 = u.pn * 256 + wc * 32 + 8 * fq;
#pragma unroll
            for (int ai = 0; ai < 2; ++ai)
#pragma unroll
                for (int m = 0; m < 4; ++m) { bf16_t* rp = Uqkv + (size_t)(row0 + ai * 128 + m * 16) * 4096 + col0;
#pragma unroll
                    for (int bj = 0; bj < 2; ++bj) { const f32x4 v0 = acc[ai][bj][m][0], v1 = acc[ai][bj][m][1];
                        u32x4 o; o.x = pk2(v0[0], v0[1]); o.y = pk2(v0[2], v0[3]); o.z = pk2(v1[0], v1[1]); o.w = pk2(v1[2], v1[3]);
                        __builtin_nontemporal_store(o, (u32x4*)(rp + bj * 128)); } }
        }
    }
};
struct EpiRes {
    static constexpr bool PERM = false;
    bf16_t* C; const bf16_t* R; bf16_t* Part;
    __device__ __forceinline__ void operator()(const f32x4 (&acc)[2][2][4][2], const pg8::Unit& u, int wr, int wc, int fr, int fq) const {
        const int row0 = u.pm * 256 + wr * 64 + fr, col0 = u.pn * 256 + wc * 32 + 4 * fq;
        if (u.part >= 0) {
            bf16_t* P = Part + (size_t)u.part * 512 * D;
#pragma unroll
            for (int ai = 0; ai < 2; ++ai)
#pragma unroll
                for (int m = 0; m < 4; ++m) { const size_t ro = (size_t)(row0 + ai * 128 + m * 16 - 8192) * D + col0;
#pragma unroll
                    for (int bj = 0; bj < 2; ++bj)
#pragma unroll
                        for (int n = 0; n < 2; ++n) { const f32x4 v = acc[ai][bj][m][n]; *(u32x2*)(P + ro + bj * 128 + n * 16) = (u32x2){pk2(v[0], v[1]), pk2(v[2], v[3])}; } }
            return;
        }
#pragma unroll
        for (int ai = 0; ai < 2; ++ai)
#pragma unroll
            for (int m = 0; m < 4; ++m) { const size_t ro = (size_t)(row0 + ai * 128 + m * 16) * D + col0;
#pragma unroll
                for (int bj = 0; bj < 2; ++bj)
#pragma unroll
                    for (int n = 0; n < 2; ++n) { const u32x2 rr = *(const u32x2*)(R + ro + bj * 128 + n * 16);
                        f32x4 v = acc[ai][bj][m][n];
                        v[0] += ALPHA * bflo(rr.x); v[1] += ALPHA * bfhi(rr.x); v[2] += ALPHA * bflo(rr.y); v[3] += ALPHA * bfhi(rr.y);
                        *(u32x2*)(C + ro + bj * 128 + n * 16) = (u32x2){pk2(v[0], v[1]), pk2(v[2], v[3])}; } }
    }
};
struct EpiSwiglu {
    static constexpr bool PERM = true;
    bf16_t* O;
    __device__ __forceinline__ void operator()(const f32x4 (&acc)[2][2][4][2], const pg8::Unit& u, int wr, int wc, int fr, int fq) const {
        const int row0 = u.pm * 256 + wr * 64 + fr, col0 = u.pn * 128 + wc * 32 + 8 * fq;
#pragma unroll
        for (int ai = 0; ai < 2; ++ai)
#pragma unroll
            for (int m = 0; m < 4; ++m) { bf16_t* rp = O + (size_t)(row0 + ai * 128 + m * 16) * DFF + col0;
                float r[8];
#pragma unroll
                for (int n = 0; n < 2; ++n)
#pragma unroll
                    for (int j = 0; j < 4; ++j) { const float gt = acc[ai][0][m][n][j], up = acc[ai][1][m][n][j];
                        r[n * 4 + j] = gt * up * __builtin_amdgcn_rcpf(1.f + __expf(-gt)); }
                u32x4 o; o.x = pk2(r[0], r[1]); o.y = pk2(r[2], r[3]); o.z = pk2(r[4], r[5]); o.w = pk2(r[6], r[7]);
                *(u32x4*)(rp) = o; }
    }
};

template <int NB, bool NTS = false> __device__ __forceinline__ void tr_item(const float* W, int ldw, int k0, int srcc0, int nvalid, bf16_t* WT, int K, int drow0, LAS unsigned* scr, int lane) {
    const int cq = (lane & 15) * 4, kq = lane >> 4;
    const float* src0 = W + (size_t)(k0 + 2 * kq) * ldw + srcc0 + cq;
#pragma unroll
    for (int hh = 0; hh < 8 / NB; ++hh) {
        f32x4 a[NB], b[NB];
#pragma unroll
        for (int ii = 0; ii < NB; ++ii) { a[ii] = (f32x4){0.f, 0.f, 0.f, 0.f}; b[ii] = a[ii];
            if (cq < nvalid) { const float* src = src0 + (size_t)(8 * (NB * hh + ii)) * ldw; a[ii] = __builtin_nontemporal_load((const f32x4*)src); b[ii] = __builtin_nontemporal_load((const f32x4*)(src + ldw)); } }
#pragma unroll
        for (int ii = 0; ii < NB; ++ii) { const int kp = 4 * (NB * hh + ii) + kq; LAS unsigned* d = scr + kp * 65 + cq;
            d[0] = pk2(a[ii][0], b[ii][0]); d[1] = pk2(a[ii][1], b[ii][1]); d[2] = pk2(a[ii][2], b[ii][2]); d[3] = pk2(a[ii][3], b[ii][3]); }
    }
    LDS_WAIT();
    const int c = lane & 7;
#pragma unroll
    for (int j = 0; j < 8; ++j) { const int n = (lane >> 3) + 8 * j; const LAS unsigned* sp = scr + (4 * c) * 65 + n;
        u32x4 o; o.x = sp[0]; o.y = sp[65]; o.z = sp[130]; o.w = sp[195];
        if constexpr (NTS) __builtin_nontemporal_store(o, (u32x4*)(WT + (size_t)(drow0 + n) * K + k0 + 8 * c)); else *(u32x4*)(WT + (size_t)(drow0 + n) * K + k0 + 8 * c) = o; }
    LDS_WAIT();
}
__device__ __forceinline__ void ln_norm(const float* g, const float* b, int lane, f32x4 (&v)[8]) {
    float s = 0.f;
#pragma unroll
    for (int j = 0; j < 8; ++j) s += (v[j][0] + v[j][1]) + (v[j][2] + v[j][3]);
    const float mean = wave_sum(s) * (1.f / D); float s2 = 0.f;
#pragma unroll
    for (int j = 0; j < 8; ++j) { v[j] = v[j] - mean; s2 += (v[j][0] * v[j][0] + v[j][1] * v[j][1]) + (v[j][2] * v[j][2] + v[j][3] * v[j][3]); }
    const float rstd = 1.f / sqrtf(wave_sum(s2) * (1.f / D) + LN_EPS);
#pragma unroll
    for (int j = 0; j < 8; ++j) { const f32x4 gg = *(const f32x4*)(g + 4 * lane + 256 * j), bb = *(const f32x4*)(b + 4 * lane + 256 * j); v[j] = v[j] * rstd * gg + bb; }
}
__device__ __forceinline__ void ln_row(const bf16_t* xrow, const float* g, const float* b, int lane, f32x4 (&v)[8]) {
#pragma unroll
    for (int j = 0; j < 8; ++j) { const u32x2 w = __builtin_nontemporal_load((const u32x2*)(xrow + 4 * lane + 256 * j)); v[j] = (f32x4){bflo(w.x), bfhi(w.x), bflo(w.y), bfhi(w.y)}; }
    ln_norm(g, b, lane, v);
}
__device__ __forceinline__ void ln_row_tail(const bf16_t* part, int nparts, int row, const bf16_t* res, const float* g, const float* b, int lane, f32x4 (&v)[8]) {
#pragma unroll
    for (int j = 0; j < 8; ++j) { const u32x2 rr = *(const u32x2*)(res + (size_t)row * D + 4 * lane + 256 * j);
        v[j] = (f32x4){ALPHA * bflo(rr.x), ALPHA * bfhi(rr.x), ALPHA * bflo(rr.y), ALPHA * bfhi(rr.y)}; }
    int pp = 0;
    for (; pp + 1 < nparts; pp += 2) { const bf16_t* pr = part + ((size_t)pp * 512 + (row - 8192)) * D + 4 * lane; const bf16_t* pr2 = pr + (size_t)512 * D;
        u32x2 a[8], b[8];
#pragma unroll
        for (int j = 0; j < 8; ++j) { a[j] = __builtin_nontemporal_load((const u32x2*)(pr + 256 * j)); b[j] = __builtin_nontemporal_load((const u32x2*)(pr2 + 256 * j)); }
#pragma unroll
        for (int j = 0; j < 8; ++j) v[j] += (f32x4){bflo(a[j].x) + bflo(b[j].x), bfhi(a[j].x) + bfhi(b[j].x), bflo(a[j].y) + bflo(b[j].y), bfhi(a[j].y) + bfhi(b[j].y)}; }
    if (pp < nparts) { const bf16_t* pr = part + ((size_t)pp * 512 + (row - 8192)) * D + 4 * lane;
#pragma unroll
        for (int j = 0; j < 8; ++j) { const u32x2 a = *(const u32x2*)(pr + 256 * j); v[j] += (f32x4){bflo(a.x), bfhi(a.x), bflo(a.y), bfhi(a.y)}; } }
    ln_norm(g, b, lane, v);
}
__device__ __forceinline__ void store_row_bf16(bf16_t* orow, int lane, const f32x4 (&v)[8]) {
#pragma unroll
    for (int j = 0; j < 8; ++j) { u32x2 o; o.x = pk2(v[j][0], v[j][1]); o.y = pk2(v[j][2], v[j][3]); *(u32x2*)(orow + 4 * lane + 256 * j) = o; }
}

template <int NB> __device__ __forceinline__ void transposes(const Params& p, LAS unsigned char* lds, int it_lo, int it_hi, int gw, int NGW, int w, int lane, bool skip_wout = false) {
    LAS unsigned* scr = (LAS unsigned*)(lds + w * 8448);
    bf16_t* Bt1 = (bf16_t*)(p.ws + WS_BT1); bf16_t* Bt2 = (bf16_t*)(p.ws + WS_BT2); bf16_t* Bt3 = (bf16_t*)(p.ws + WS_BT3); bf16_t* Bt4 = (bf16_t*)(p.ws + WS_BT4);
    constexpr int NB1 = N1 / 64, NB2 = D / 64, NB3 = N3 / 64, NB4 = D / 64;
    constexpr int I1 = 32 * NB1, I2 = 32 * NB2, I3 = 32 * NB3;
    for (int it = it_lo + gw; it < it_hi; it += NGW) {
        int r = it; if (skip_wout && r >= 32 * (N1 / 64)) r += 32 * (D / 64);
        if (r < I1) { const int kb = r / NB1, n0 = (r % NB1) * 64; int src, nv;
            if (n0 < 4096) { src = n0; nv = 64; }
            else if (n0 < 16384) {
                const int grp = (n0 - 4096) >> 12, rel = (n0 - 4096) & 4095, hf = (rel >> 7) & 1;
                const int base = grp == 0 ? (hf ? 12304 : 4096) : (grp == 1 ? (hf ? 10256 : 8208) : (hf ? 14352 : 6160));
                src = base + (rel >> 8) * 128 + (rel & 127); nv = 64; }
            else if (n0 == 16384) { src = 6144; nv = 16; } else { src = 0; nv = 0; }
            tr_item<NB>(p.in[7], 16400, kb * 64, src, nv, Bt1, D, n0, scr, lane); continue; }
        r -= I1;
        if (r < I2) { const int kb = r / NB2, n0 = (r % NB2) * 64; tr_item<NB, true>(p.in[12], D, kb * 64, n0, 64, Bt2, D, n0, scr, lane); continue; }
        r -= I2;
        if (r < I3) { const int kb = r / NB3, n0 = (r % NB3) * 64; const int src = ((n0 >> 7) & 1) * DFF + (n0 >> 8) * 128 + (n0 & 127);
            tr_item<NB, true>(p.in[15], N3, kb * 64, src, 64, Bt3, D, n0, scr, lane); continue; }
        r -= I3;
        { const int kb = r / NB4, n0 = (r % NB4) * 64; tr_item<NB, true>(p.in[16], D, kb * 64, n0, 64, Bt4, DFF, n0, scr, lane); }
    }
}
constexpr int TR_I1 = 32 * (N1 / 64), TR_ALL = TR_I1 + 32 * (D / 64) + 32 * (N3 / 64) + (DFF / 64) * (D / 64);
constexpr int TR_SPLIT = TR_ALL;
constexpr int TR_IDLE = 3760;
__device__ __forceinline__ void phase0(const Params& p, LAS unsigned char* lds) {
    const int tid_ = fresh_tid(); const int lane = tid_ & 63, w = tid_ >> 6;
    const int gw = blockIdx.x * 8 + w, NGW = gridDim.x * 8;
    transposes<8>(p, lds, 0, TR_ALL - TR_IDLE - 32 * (D / 64), gw, NGW, w, lane, true);
    bf16_t* XN = (bf16_t*)(p.ws + WS_XN);
    for (int row = gw; row < MP; row += NGW) {
        bf16_t* orow = XN + (size_t)row * D;
        if (row < ROW_META || row >= ROW_END) {
#pragma unroll
            for (int j = 0; j < 8; ++j) *(u32x2*)(orow + 4 * lane + 256 * j) = (u32x2){0u, 0u};
            continue;
        }
        const float* xr = row < ROW_PROMPT ? p.in[4] + (size_t)(row - ROW_META) * D : (row < ROW_SAMPLE ? p.in[0] + (size_t)(row - ROW_PROMPT) * D : p.in[1] + (size_t)(row - ROW_SAMPLE) * D);
        f32x4 v[8];
#pragma unroll
        for (int j = 0; j < 8; ++j) v[j] = __builtin_nontemporal_load((const f32x4*)(xr + 4 * lane + 256 * j));
        ln_norm(p.in[5], p.in[6], lane, v); store_row_bf16(orow, lane, v);
    }
}

__device__ __forceinline__ float logsigmoid(float z) { return fminf(z, 0.f) - __logf(1.f + __expf(-fabsf(z))); }
__device__ __forceinline__ void gla_prep_item(const Params& p, LAS unsigned char* lds, int it) {
    const int tid = threadIdx.x, lane = tid & 63, w = tid >> 6, l15 = lane & 15, quad = lane >> 4;
    const int slot = it >> 2, h = it & 3;
    const int row0 = slot == 0 ? ROW_META : (slot < 129 ? slot * 64 : ROW_SAMPLE + (slot - 129) * 16);
    const int ntok = (slot == 0 || slot >= 129) ? 16 : 64;
    const float* Abuf = (const float*)(p.ws + WS_A);
    const bf16_t* Uqkv = (const bf16_t*)(p.ws + WS_UQKV);
    bf16_t* QT = (bf16_t*)(p.ws + WS_QT); bf16_t* KD = (bf16_t*)(p.ws + WS_KD); bf16_t* PM = (bf16_t*)(p.ws + WS_PM); float* DL = (float*)(p.ws + WS_DL); bf16_t* VT = (bf16_t*)(p.ws + WS_VT);
    LAS float* sA = (LAS float*)lds;
    LAS float* sTot = (LAS float*)(lds + 4096);
    LAS unsigned char* sQ = lds + 8192;
    LAS unsigned char* sK = lds + 8192 + 33792;
    if (tid < 256) { const int tok = tid >> 2, c4 = (tid & 3) * 4; f32x4 v = {0.f, 0.f, 0.f, 0.f};
        if (tok < ntok) v = *(const f32x4*)(Abuf + (size_t)(row0 + tok) * 16 + c4);
        *(LAS f32x4*)(sA + tok * 16 + c4) = v; }
#pragma unroll
    for (int j = 0; j < 8; ++j) { const int c = tid + 512 * j, isk = c >> 11, tok = (c >> 5) & 63, cc = c & 31;
        u32x4 v = {0u, 0u, 0u, 0u};
        if (tok < ntok) v = __builtin_nontemporal_load((const u32x4*)(Uqkv + (size_t)(row0 + tok) * 4096 + isk * 1024 + h * 256 + cc * 8));
        *(LAS u32x4*)((isk ? sK : sQ) + tok * 528 + cc * 16) = v; }
    __syncthreads();
    const int d = tid & 255, half = tid >> 8;
    float wg[16];
#pragma unroll
    for (int r = 0; r < 16; ++r) wg[r] = p.in[8][r * 1024 + h * 256 + d];
    const float bg = p.in[9][h * 256 + d];
    float bb[32]; float run = 0.f;
#pragma unroll
    for (int i = 0; i < 32; ++i) { const int tok = half * 32 + i;
        const f32x4 a0 = *(const LAS f32x4*)(sA + tok * 16), a1 = *(const LAS f32x4*)(sA + tok * 16 + 4), a2 = *(const LAS f32x4*)(sA + tok * 16 + 8), a3 = *(const LAS f32x4*)(sA + tok * 16 + 12);
        float z = bg;
        z += a0[0] * wg[0] + a0[1] * wg[1] + a0[2] * wg[2] + a0[3] * wg[3];
        z += a1[0] * wg[4] + a1[1] * wg[5] + a1[2] * wg[6] + a1[3] * wg[7];
        z += a2[0] * wg[8] + a2[1] * wg[9] + a2[2] * wg[10] + a2[3] * wg[11];
        z += a3[0] * wg[12] + a3[1] * wg[13] + a3[2] * wg[14] + a3[3] * wg[15];
        float g = logsigmoid(z) * (1.f / 16.f);
        if (tok >= ntok) g = 0.f;
        run += g; bb[i] = run; }
    sTot[half * 256 + d] = run;
    __syncthreads();
    const float t0 = sTot[d], t1 = sTot[256 + d];
    const float off = half ? t0 : 0.f, blast = t0 + t1;
    if (half == 0) DL[(size_t)it * 256 + d] = __expf(blast);
    const int dl5 = d & 31;
    const int pos = (d & ~31) + ((dl5 < 16) ? ((dl5 >> 2) * 8 + (dl5 & 3)) : (((dl5 - 16) >> 2) * 8 + 4 + (dl5 & 3)));
    unsigned kdp[16];
    const float eblast = __expf(blast);
#pragma unroll
    for (int i = 0; i < 32; i += 2) { const int tok = half * 32 + i;
        const float q0 = bf2f(*(const LAS bf16_t*)(sQ + tok * 528 + d * 2)), q1 = bf2f(*(const LAS bf16_t*)(sQ + (tok + 1) * 528 + d * 2));
        const float k0 = bf2f(*(const LAS bf16_t*)(sK + tok * 528 + d * 2)), k1 = bf2f(*(const LAS bf16_t*)(sK + (tok + 1) * 528 + d * 2));
        const float e0 = __expf(off + bb[i]), e1 = __expf(off + bb[i + 1]);
        const float r0 = __builtin_amdgcn_rcpf(e0), r1 = __builtin_amdgcn_rcpf(e1);
        const float kt0 = k0 * r0, kt1 = k1 * r1;
        const unsigned qq = pk2(q0 * 0.0625f * e0, q1 * 0.0625f * e1);
        const unsigned kk = pk2(kt0, kt1);
        asm volatile("s_waitcnt lgkmcnt(0)" ::: "memory");
        *(LAS bf16_t*)(sQ + tok * 528 + pos * 2) = (bf16_t)(qq & 0xffffu); *(LAS bf16_t*)(sQ + (tok + 1) * 528 + pos * 2) = (bf16_t)(qq >> 16);
        *(LAS bf16_t*)(sK + tok * 528 + pos * 2) = (bf16_t)(kk & 0xffffu); *(LAS bf16_t*)(sK + (tok + 1) * 528 + pos * 2) = (bf16_t)(kk >> 16);
        kdp[i >> 1] = pk2(kt0 * eblast, kt1 * eblast); }
    {
      bf16_t* kr = KD + (size_t)it * 16384 + (size_t)((((d >> 5) * 2 + ((d >> 4) & 1)) * 2 + half) * 64 + (d & 15)) * 8;
#pragma unroll
      for (int j = 0; j < 4; ++j) *(u32x4*)(kr + j * 128) = (u32x4){kdp[4 * j], kdp[4 * j + 1], kdp[4 * j + 2], kdp[4 * j + 3]}; }
    __syncthreads();
#pragma unroll
    for (int j = 0; j < 4; ++j) { const int c = tid + 512 * j, ln = c & 63, tt = (c >> 6) & 3, ww = c >> 8;
        *(u32x4*)(QT + (size_t)it * 16384 + (size_t)c * 8) = *(const LAS u32x4*)(sQ + (tt * 16 + (ln & 15)) * 528 + (32 * ww + (ln >> 4) * 8) * 2); }
#pragma unroll
    for (int e = 0; e < 2; ++e) { const int id = 2 * w + e, ti = id >> 2, tj = id & 3;
        f32x4 acc = {0.f, 0.f, 0.f, 0.f};
        if (tj <= ti) {
#pragma unroll
            for (int ks = 0; ks < 8; ++ks) { const bf16x8 A = *(const LAS bf16x8*)(sK + (tj * 16 + l15) * 528 + ks * 64 + quad * 16), B = *(const LAS bf16x8*)(sQ + (ti * 16 + l15) * 528 + ks * 64 + quad * 16);
                acc = __builtin_amdgcn_mfma_f32_16x16x32_bf16(A, B, acc, 0, 0, 0); }
        }
        const int i = ti * 16 + l15, j0 = tj * 16 + quad * 4;
#pragma unroll
        for (int r = 0; r < 4; ++r) if (j0 + r > i) acc[r] = 0.f;
        *(u32x2*)(PM + (size_t)it * 4096 + (size_t)(((ti * 2 + (tj >> 1)) * 64 + ((tj & 1) * 2 + (quad >> 1)) * 16 + l15) * 8 + (quad & 1) * 4)) = (u32x2){pk2(acc[0], acc[1]), pk2(acc[2], acc[3])}; }
#pragma unroll
    for (int ps = 0; ps < 2; ++ps) { const int c = ps * 256 + d; unsigned vp[16];
#pragma unroll
        for (int i = 0; i < 32; i += 2) { const int tok = half * 32 + i; unsigned v0 = 0, v1 = 0;
            if (tok < ntok) { const bf16_t* ur = Uqkv + (size_t)(row0 + tok) * 4096 + 2048 + h * 512 + c; v0 = __builtin_nontemporal_load(ur); v1 = __builtin_nontemporal_load(ur + 4096); }
            vp[i >> 1] = v0 | (v1 << 16); }
        bf16_t* vr = VT + (size_t)it * 32768 + (size_t)(((c >> 4) * 2 + half) * 64 + (c & 15)) * 8;
#pragma unroll
        for (int j = 0; j < 4; ++j) *(u32x4*)(vr + j * 128) = (u32x4){vp[4 * j], vp[4 * j + 1], vp[4 * j + 2], vp[4 * j + 3]}; }
    __syncthreads();
}

struct ScanOps { bf16x8 q[4]; bf16x8 kd[2][2]; bf16x8 v[2]; bf16x8 pp[2]; f32x4 dl[2]; };
__device__ __forceinline__ void scan_load(const Params& p, ScanOps& o, int it, int kw, int vt16, int khalf, int kq, int l15, int quad) {
    const bf16_t* QT = (const bf16_t*)(p.ws + WS_QT); const bf16_t* KD = (const bf16_t*)(p.ws + WS_KD); const bf16_t* PM = (const bf16_t*)(p.ws + WS_PM);
    const float* DL = (const float*)(p.ws + WS_DL); const bf16_t* VT = (const bf16_t*)(p.ws + WS_VT);
    const int lane = quad * 16 + l15;
#pragma unroll
    for (int tt = 0; tt < 4; ++tt) o.q[tt] = *(const bf16x8*)(QT + (size_t)it * 16384 + (size_t)((kw * 4 + tt) * 64 + lane) * 8);
#pragma unroll
    for (int t = 0; t < 2; ++t)
#pragma unroll
        for (int ks = 0; ks < 2; ++ks) o.kd[t][ks] = *(const bf16x8*)(KD + (size_t)it * 16384 + (size_t)(((kw * 2 + t) * 2 + ks) * 64 + lane) * 8);
#pragma unroll
    for (int ks = 0; ks < 2; ++ks) o.v[ks] = *(const bf16x8*)(VT + (size_t)it * 32768 + (size_t)((vt16 * 2 + ks) * 64 + lane) * 8);
    const bf16_t* pbase = khalf == 0 ? PM + (size_t)it * 4096 + (size_t)(kq * 2 * 64) * 8 : (const bf16_t*)(p.ws + WS_ZERO) - (size_t)0;
#pragma unroll
    for (int ks = 0; ks < 2; ++ks) o.pp[ks] = *(const bf16x8*)(pbase + (khalf == 0 ? (size_t)(ks * 64 + lane) * 8 : (size_t)(lane & 31) * 8));
#pragma unroll
    for (int t = 0; t < 2; ++t) o.dl[t] = *(const f32x4*)(DL + (size_t)it * 256 + 32 * kw + 16 * t + quad * 4);
}
__device__ __forceinline__ void gla_step(LAS float* red, const ScanOps& cur, f32x4 (&S)[2], int kq, int lane, int& step) {
    const int buf = step & 1; ++step;
    u32x4 sp; sp.x = pk2(S[0][0], S[0][1]); sp.y = pk2(S[0][2], S[0][3]); sp.z = pk2(S[1][0], S[1][1]); sp.w = pk2(S[1][2], S[1][3]);
    const bf16x8 Sb = __builtin_bit_cast(bf16x8, sp);
    f32x4 ao[4];
#pragma unroll
    for (int tt = 0; tt < 4; ++tt) ao[tt] = __builtin_amdgcn_mfma_f32_16x16x32_bf16(cur.q[tt], Sb, (f32x4){0.f, 0.f, 0.f, 0.f}, 0, 0, 0);
    f32x4 ai = {0.f, 0.f, 0.f, 0.f};
#pragma unroll
    for (int ks = 0; ks < 2; ++ks) ai = __builtin_amdgcn_mfma_f32_16x16x32_bf16(cur.pp[ks], cur.v[ks], ai, 0, 0, 0);
    LAS float* rw = red + (buf * 6 + kq) * 1024 + lane * 4;
#pragma unroll
    for (int tt = 0; tt < 4; ++tt) *(LAS f32x4*)(rw + tt * 256) = ao[tt];
    *(LAS f32x4*)(red + (buf * 6 + 4) * 1024 + (kq * 64 + lane) * 4) = ai;
    asm volatile("s_waitcnt lgkmcnt(0)" ::: "memory"); __builtin_amdgcn_s_barrier(); asm volatile("" ::: "memory");
#pragma unroll
    for (int t = 0; t < 2; ++t) { f32x4 u = {0.f, 0.f, 0.f, 0.f};
#pragma unroll
        for (int ks = 0; ks < 2; ++ks) u = __builtin_amdgcn_mfma_f32_16x16x32_bf16(cur.kd[t][ks], cur.v[ks], u, 0, 0, 0);
        S[t] = cur.dl[t] * S[t] + u; }
}
__device__ __forceinline__ void gla_consume(const Params& p, LAS float* red, int c, int slot, int h, int khalf, int vs16, int& step) {
    const int buf = step & 1; ++step;
    asm volatile("" ::: "memory"); __builtin_amdgcn_s_barrier(); asm volatile("" ::: "memory");
    bf16_t* O = (bf16_t*)(p.ws + WS_O) + (size_t)khalf * MP * D;
    f32x4 sum = *(const LAS f32x4*)(red + (buf * 6 + 4) * 1024 + c * 4);
#pragma unroll
    for (int k4 = 0; k4 < 4; ++k4) sum += *(const LAS f32x4*)(red + (buf * 6 + k4) * 1024 + c * 4);
    const int tt = c >> 6, ln = c & 63, tok0 = 16 * tt + (ln >> 4) * 4;
    const int ntok = (slot == 0 || slot >= 129) ? 16 : 64, row0 = slot == 0 ? ROW_META : (slot < 129 ? slot * 64 : ROW_SAMPLE + (slot - 129) * 16);
    const int rowb = tok0 < ntok ? row0 + tok0 : ROW_END + tok0;
    bf16_t* op = O + (size_t)rowb * D + h * 512 + vs16 * 16 + (ln & 15);
    const unsigned w01 = pk2(sum[0], sum[1]), w23 = pk2(sum[2], sum[3]);
    op[0] = (bf16_t)(w01 & 0xffffu); op[D] = (bf16_t)(w01 >> 16); op[2 * D] = (bf16_t)(w23 & 0xffffu); op[3 * D] = (bf16_t)(w23 >> 16);
}
__device__ __forceinline__ void gla_chain(const Params& p, LAS unsigned char* lds, int slot0, int nslots, int h, int khalf, int vs16, float* Sout, int& step) {
    const int tid = fresh_tid(), lane = tid & 63, w = __builtin_amdgcn_readfirstlane(tid >> 6), l15 = lane & 15, quad = lane >> 4;
    LAS float* red = (LAS float*)lds;
    if (w >= 4) { for (int s = 0; s < nslots; ++s) gla_consume(p, red, tid - 256, slot0 + s, h, khalf, vs16, step); return; }
    const int kq = w, kw = khalf * 4 + kq;
    f32x4 S[2];
#pragma unroll
    for (int t = 0; t < 2; ++t) S[t] = (f32x4){0.f, 0.f, 0.f, 0.f};
    const int last = slot0 + nslots - 1;
    ScanOps A, B;
    scan_load(p, A, slot0 * 4 + h, kw, vs16, khalf, kq, l15, quad);
    int s = 0;
    for (; s + 1 < nslots; s += 2) {
        scan_load(p, B, (slot0 + s + 1) * 4 + h, kw, vs16, khalf, kq, l15, quad);
        gla_step(red, A, S, kq, lane, step);
        { const int sn = slot0 + s + 2 < last ? slot0 + s + 2 : last; scan_load(p, A, sn * 4 + h, kw, vs16, khalf, kq, l15, quad); }
        gla_step(red, B, S, kq, lane, step);
    }
    if (s < nslots) gla_step(red, A, S, kq, lane, step);
#pragma unroll
    for (int t = 0; t < 2; ++t)
#pragma unroll
        for (int r = 0; r < 4; ++r) Sout[(size_t)(32 * kw + 16 * t + quad * 4 + r) * 512 + vs16 * 16 + l15] = S[t][r];
}

struct SampItem { int slot, h, khalf, vs16, sh; };
__device__ __forceinline__ SampItem samp_decode(int i2) { SampItem m; m.sh = i2 >> 6; m.slot = 129 + (m.sh >> 2); m.h = m.sh & 3; m.khalf = (i2 >> 5) & 1; m.vs16 = i2 & 31; return m; }
__device__ __forceinline__ void samp_load(const Params& p, const SampItem& m, ScanOps& o, f32x4 (&S)[2], int kq, int l15, int quad) {
    const int kw = m.khalf * 4 + kq;
    scan_load(p, o, m.slot * 4 + m.h, kw, m.vs16, m.khalf, kq, l15, quad);
    const float* S0 = p.in[2] + (size_t)m.sh * 256 * 512 + (size_t)(32 * kw + quad * 4) * 512 + m.vs16 * 16 + l15;
#pragma unroll
    for (int t = 0; t < 2; ++t)
#pragma unroll
        for (int r = 0; r < 4; ++r) S[t][r] = __builtin_nontemporal_load(S0 + (size_t)(16 * t + r) * 512);
}
__device__ __forceinline__ void samp_store(const Params& p, const SampItem& m, const f32x4 (&S)[2], int kq, int l15, int quad) {
    const int kw = m.khalf * 4 + kq;
    float* So = p.out + OUT_SS + (size_t)m.sh * 256 * 512 + (size_t)(32 * kw + quad * 4) * 512 + m.vs16 * 16 + l15;
#pragma unroll
    for (int t = 0; t < 2; ++t)
#pragma unroll
        for (int r = 0; r < 4; ++r) __builtin_nontemporal_store(S[t][r], So + (size_t)(16 * t + r) * 512);
}
__device__ __forceinline__ void gla_samples(const Params& p, LAS unsigned char* lds, int i2_first, int stride, int n, int& step) {
    const int tid = fresh_tid(), lane = tid & 63, w = __builtin_amdgcn_readfirstlane(tid >> 6), l15 = lane & 15, quad = lane >> 4;
    LAS float* red = (LAS float*)lds;
    if (w >= 4) { for (int j = 0; j < n; ++j) { const SampItem m = samp_decode(i2_first + j * stride); gla_consume(p, red, tid - 256, m.slot, m.h, m.khalf, m.vs16, step); } return; }
    const int kq = w;
    SampItem ma = samp_decode(i2_first), mb = ma; ScanOps A, B; f32x4 SA[2], SB[2];
    samp_load(p, ma, A, SA, kq, l15, quad);
    int j = 0;
    for (; j + 1 < n; j += 2) {
        mb = samp_decode(i2_first + (j + 1) * stride); samp_load(p, mb, B, SB, kq, l15, quad);
        gla_step(red, A, SA, kq, lane, step); samp_store(p, ma, SA, kq, l15, quad);
        ma = samp_decode(i2_first + (j + 2 < n ? j + 2 : n - 1) * stride); samp_load(p, ma, A, SA, kq, l15, quad);
        gla_step(red, B, SB, kq, lane, step); samp_store(p, mb, SB, kq, l15, quad);
    }
    if (j < n) { gla_step(red, A, SA, kq, lane, step); samp_store(p, ma, SA, kq, l15, quad); }
}

__device__ __forceinline__ void unpack8(const u32x4 w, float (&f)[8]) { f[0] = bflo(w.x); f[1] = bfhi(w.x); f[2] = bflo(w.y); f[3] = bfhi(w.y); f[4] = bflo(w.z); f[5] = bfhi(w.z); f[6] = bflo(w.w); f[7] = bfhi(w.w); }
__device__ __forceinline__ float sigmoidf_(float x) { return __builtin_amdgcn_rcpf(1.f + __expf(-x)); }
__device__ __forceinline__ void conv_prev(const Params& p, int t, int k, int col, float (&out)[8]) {
    const bf16_t* Ur = (const bf16_t*)(p.ws + WS_UREST);
    const bool samp = t >= ROW_SAMPLE && t < ROW_END; const int si = (t - ROW_SAMPLE) & 15, stream = (t - ROW_SAMPLE) >> 4;
    if (samp && si < k) { const float* c = p.in[3] + ((size_t)stream * 2 + (si - k + 2)) * D + col;
        const f32x4 a = *(const f32x4*)c, b = *(const f32x4*)(c + 4);
#pragma unroll
        for (int j = 0; j < 4; ++j) { out[j] = a[j]; out[4 + j] = b[j]; }
    } else if (t - k >= 0) { unpack8(*(const u32x4*)(Ur + (size_t)(t - k) * 6144 + 2048 + col), out);
    } else {
#pragma unroll
        for (int j = 0; j < 8; ++j) out[j] = 0.f;
    }
}
struct MixIn { u32x4 o, o1, g1, g2, pc; };
__device__ __forceinline__ void mix_load(const Params& p, MixIn& m, int row, int col) {
    const bf16_t* ur = (const bf16_t*)(p.ws + WS_UREST) + (size_t)row * 6144 + col;
    m.o = __builtin_nontemporal_load((const u32x4*)((const bf16_t*)(p.ws + WS_O) + (size_t)row * D + col)); m.o1 = __builtin_nontemporal_load((const u32x4*)((const bf16_t*)(p.ws + WS_O) + (size_t)MP * D + (size_t)row * D + col));
    m.g1 = __builtin_nontemporal_load((const u32x4*)(ur)); m.pc = __builtin_nontemporal_load((const u32x4*)(ur + 2048)); m.g2 = __builtin_nontemporal_load((const u32x4*)(ur + 4096));
}
__device__ __forceinline__ void phase_mix(const Params& p) {
    const int tid_ = fresh_tid(); const int lane = tid_ & 63, w = tid_ >> 6, g = w & 3, half = w >> 2;
    const int col = g * 512 + lane * 8;
    bf16_t* Mb = (bf16_t*)(p.ws + WS_M);
    float gn[8], w0[8], w1[8], w2[8];
    { const float* gp = p.in[10] + col; const float* cp = p.in[11] + col;
#pragma unroll
      for (int j = 0; j < 8; ++j) { gn[j] = gp[j]; w0[j] = cp[j]; w1[j] = cp[D + j]; w2[j] = cp[2 * D + j]; } }
    const int rbeg = blockIdx.x * 34 + half * 17, rend = rbeg + 17;
    float p1[8], p2[8];
    conv_prev(p, rbeg, 1, col, p1); conv_prev(p, rbeg, 2, col, p2);
    MixIn cur; mix_load(p, cur, rbeg, col);
#pragma unroll 1
    for (int row = rbeg; row < rend; ++row) {
        MixIn nx; mix_load(p, nx, row + 1 < rend ? row + 1 : row, col);
        const bool samp = row >= ROW_SAMPLE && row < ROW_END; const int si = (row - ROW_SAMPLE) & 15, stream = (row - ROW_SAMPLE) >> 4;
        if (samp && si == 0) { conv_prev(p, row, 1, col, p1); conv_prev(p, row, 2, col, p2); }
        float o[8], g1[8], g2[8];
        { float ob[8]; unpack8(cur.o, o); unpack8(cur.o1, ob);
#pragma unroll
          for (int j = 0; j < 8; ++j) o[j] += ob[j]; }
        unpack8(cur.g1, g1); unpack8(cur.g2, g2);
        float ss = 0.f;
#pragma unroll
        for (int j = 0; j < 8; ++j) ss += o[j] * o[j];
        const float rs = 1.f / sqrtf(wave_sum(ss) * (1.f / 512.f) + RMS_EPS);
        const bool valid = row >= ROW_META && row < ROW_END;
        float mm[8], p0[8]; unpack8(cur.pc, p0);
#pragma unroll
        for (int j = 0; j < 8; ++j) {
            const float ya = o[j] * rs * gn[j] * g1[j];
            const float cv = w0[j] * p2[j] + w1[j] * p1[j] + w2[j] * p0[j];
            mm[j] = valid ? ya + g2[j] * cv : 0.f;
        }
        *(u32x4*)(Mb + (size_t)row * D + col) = (u32x4){pk2(mm[0], mm[1]), pk2(mm[2], mm[3]), pk2(mm[4], mm[5]), pk2(mm[6], mm[7])};
        float* co = nullptr;
        if (row == ROW_SAMPLE - 2) co = p.out + OUT_CP; else if (row == ROW_SAMPLE - 1) co = p.out + OUT_CP + D;
        else if (samp && si == 14) co = p.out + OUT_CS + ((size_t)stream * 2 + 0) * D; else if (samp && si == 15) co = p.out + OUT_CS + ((size_t)stream * 2 + 1) * D;
        if (co) { *(f32x4*)(co + col) = (f32x4){p0[0], p0[1], p0[2], p0[3]}; *(f32x4*)(co + col + 4) = (f32x4){p0[4], p0[5], p0[6], p0[7]}; }
#pragma unroll
        for (int j = 0; j < 8; ++j) { p2[j] = p1[j]; p1[j] = p0[j]; }
        cur = nx;
    }
}

__device__ __forceinline__ void phase_ln1(const Params& p) {
    const int tid_ = fresh_tid(); const int lane = tid_ & 63, w = tid_ >> 6; const int gw = blockIdx.x * 8 + w, NGW = gridDim.x * 8;
    const bf16_t* T = (const bf16_t*)(p.ws + WS_T1); bf16_t* H = (bf16_t*)(p.ws + WS_H);
    const bf16_t* Part = (const bf16_t*)(p.ws + WS_PART); const bf16_t* XN = (const bf16_t*)(p.ws + WS_XN);
    for (int row = gw; row < MP; row += NGW) { f32x4 v[8];
        if (row < 8192) ln_row(T + (size_t)row * D, p.in[13], p.in[14], lane, v); else ln_row_tail(Part, 8, row, XN, p.in[13], p.in[14], lane, v);
        store_row_bf16(H + (size_t)row * D, lane, v); }
}
__device__ __forceinline__ void phase_ln2(const Params& p) {
    const int tid_ = fresh_tid(); const int lane = tid_ & 63, w = tid_ >> 6; const int gw = blockIdx.x * 8 + w, NGW = gridDim.x * 8;
    const bf16_t* T = (const bf16_t*)(p.ws + WS_T2);
    const bf16_t* Part = (const bf16_t*)(p.ws + WS_PART); const bf16_t* H = (const bf16_t*)(p.ws + WS_H);
    for (int row = ROW_PROMPT + gw; row < ROW_END; row += NGW) { f32x4 v[8];
        if (row < 8192) ln_row(T + (size_t)row * D, p.in[17], p.in[18], lane, v); else ln_row_tail(Part, 11, row, H, p.in[17], p.in[18], lane, v);
        float* orow = row < ROW_SAMPLE ? p.out + OUT_YP + (size_t)(row - ROW_PROMPT) * D : p.out + OUT_YS + (size_t)(row - ROW_SAMPLE) * D;
#pragma unroll
        for (int j = 0; j < 8; ++j) __builtin_nontemporal_store(v[j], (f32x4*)(orow + 4 * lane + 256 * j)); }
}


#define XB_TMO      128
#define XB_XCNT(j)  (256  + 64 * (j))
#define XB_XSUB(j)  (1280 + 64 * (j))
#define XB_XGEN(j)  (2304 + 64 * (j))
#define XB_TOP      3328
#define XB_TOPGEN   3392
#define XCD_BAR_WORDS 3456
#define XB_SPIN_CAP (1u << 18)
__device__ __forceinline__ unsigned xb_ld(unsigned* p)              { return __hip_atomic_load(p, __ATOMIC_RELAXED, __HIP_MEMORY_SCOPE_AGENT); }
__device__ __forceinline__ unsigned xb_add(unsigned* p, unsigned v) { return __hip_atomic_fetch_add(p, v, __ATOMIC_RELAXED, __HIP_MEMORY_SCOPE_AGENT); }
__device__ __forceinline__ unsigned xb_xcc_id() { return (unsigned)__builtin_amdgcn_s_getreg((3 << 11) | 20) & 0xFu; }
#define XB_SPIN(cond, bar) do { unsigned _sp = 0; while (cond) { __builtin_amdgcn_s_sleep(1); \
    if ((++_sp & 255u) == 0u) { if (xb_ld(&(bar)[XB_TMO])) break; if (_sp > XB_SPIN_CAP) { atomicAdd(&(bar)[XB_TMO], 1u); break; } } } } while (0)
struct XcdBarrier { unsigned* bar; unsigned x; volatile LAS unsigned* st; };
__device__ __forceinline__ XcdBarrier xcd_barrier_post(unsigned* bar, volatile LAS unsigned* st) {
    XcdBarrier b; b.bar = bar; b.x = xb_xcc_id(); b.st = st;
    if (threadIdx.x == 0) (void)xb_add(&bar[XB_XCNT(b.x)], 1u);
    return b;
}
__device__ __forceinline__ void xcd_barrier_complete(unsigned* bar, unsigned x, unsigned& nloc, unsigned& nx) {
    const unsigned G = gridDim.x * gridDim.y * gridDim.z;
    unsigned sum, cnt, mine, sp = 0u;
    for (;;) {
        sum = 0u; cnt = 0u; mine = 0u;
#pragma unroll
        for (unsigned j = 0; j < 16; ++j) { const unsigned c = xb_ld(&bar[XB_XCNT(j)]); sum += c; cnt += (c > 0u) ? 1u : 0u; mine = (j == x) ? c : mine; }
        if (sum == G) break;
        __builtin_amdgcn_s_sleep(1);
        if ((++sp & 255u) == 0u) { if (xb_ld(&bar[XB_TMO])) break; if (sp > XB_SPIN_CAP) { atomicAdd(&bar[XB_TMO], 1u); break; } }
    }
    nloc = mine > 0u ? mine : 1u; nx = cnt > 0u ? cnt : 1u;
}
__device__ __forceinline__ void xcd_barrier(const XcdBarrier& b) {
    asm volatile("s_waitcnt vmcnt(0)" ::: "memory");
    __syncthreads();
    if (threadIdx.x == 0) {
        unsigned* bar = b.bar;
        __builtin_amdgcn_s_waitcnt(0);
        unsigned nloc = b.st[0], nx = b.st[1];
        if (nloc == 0u) { xcd_barrier_complete(bar, b.x, nloc, nx); b.st[0] = nloc; b.st[1] = nx; }
        const unsigned old = xb_add(&bar[XB_XSUB(b.x)], 1u);
        const unsigned gen = old / nloc;
        if (old + 1u == (gen + 1u) * nloc) {
            __builtin_amdgcn_fence(__ATOMIC_RELEASE, "agent");
            asm volatile("s_waitcnt vmcnt(0)" ::: "memory");
            const unsigned og = xb_add(&bar[XB_TOP], 1u);
            const unsigned tg = og / nx;
            if (og + 1u == (tg + 1u) * nx) xb_add(&bar[XB_TOPGEN], 1u);
            else XB_SPIN(xb_ld(&bar[XB_TOPGEN]) == tg, bar);
            __builtin_amdgcn_fence(__ATOMIC_ACQUIRE, "agent");
            xb_add(&bar[XB_XGEN(b.x)], 1u);
            asm volatile("s_waitcnt vmcnt(0)" ::: "memory");
        } else {
            XB_SPIN(xb_ld(&bar[XB_XGEN(b.x)]) == gen, bar);
            __builtin_amdgcn_fence(__ATOMIC_ACQUIRE, "agent");
            asm volatile("s_waitcnt vmcnt(0)" ::: "memory");
        }
    }
    __syncthreads();
}

#ifndef DUP
#define DUP 0
#ifndef DUPC
#define DUPC 0
#endif
#ifndef DUPS
#define DUPS 0
#endif
#endif
#define REP(bit) for (int _rep = 0; _rep < (((DUP) >> (bit)) & 1) + 1; ++_rep)
__global__ void __launch_bounds__(512, 2) fwd_megakernel(Params p) {
    extern __shared__ __attribute__((aligned(16))) unsigned char shm_raw[];
    LAS unsigned char* lds = (LAS unsigned char*)shm_raw;
    cg::grid_group grid = cg::this_grid();
    const int G = gridDim.x, bid = blockIdx.x;
    if (p.ws == nullptr) grid.sync();
    volatile LAS unsigned* xst = (volatile LAS unsigned*)(lds + pg8::STAGE_BYTES);
    if (threadIdx.x == 0) { xst[0] = 0u; xst[1] = 0u; }
    __syncthreads();
    const XcdBarrier xb = xcd_barrier_post((unsigned*)(p.ws + WS_BAR), xst);

    REP(0) { phase0(p, lds);
    xcd_barrier(xb); }
    REP(1) { pg8::Gemm g{(const bf16_t*)(p.ws + WS_XN), (const bf16_t*)(p.ws + WS_BT1), MP, N1, D};
      pg8::StaticOrder S; S.init(MP, N1, D, G, bid);
      EpiU E{(bf16_t*)(p.ws + WS_UQKV), (bf16_t*)(p.ws + WS_UREST), (float*)(p.ws + WS_A)};
      pg8::gemm_phase<EpiU, pg8::StaticOrder, true, true>(lds, g, S, E);
      if (bid >= 162) { const int tid_ = fresh_tid(); transposes<4>(p, lds, TR_ALL - TR_IDLE, TR_ALL, (bid - 162) * 8 + (tid_ >> 6), 94 * 8, tid_ >> 6, tid_ & 63); }
    xcd_barrier(xb); }
    REP(2) { for (int it = bid; it < NITEM; it += G) gla_prep_item(p, lds, it);
      if (bid >= 68) { const int tid_ = fresh_tid(); transposes<4>(p, lds, TR_I1, TR_I1 + 32 * (D / 64), (bid - 68) * 8 + (tid_ >> 6), 188 * 8, tid_ >> 6, tid_ & 63); }
    xcd_barrier(xb); }
    REP(3) { int step = 0;
      gla_chain(p, lds, 0, 129, (bid & 7) >> 1, bid & 1, bid >> 3, p.out + OUT_SP + (size_t)((bid & 7) >> 1) * 256 * 512, step);
      __syncthreads();
      gla_samples(p, lds, ((bid & 7) >> 1) * 64 + (bid & 1) * 32 + (bid >> 3), 256, 16, step);
    xcd_barrier(xb); }
    REP(4) { phase_mix(p);
    xcd_barrier(xb); }
    REP(5) { pg8::Gemm g{(const bf16_t*)(p.ws + WS_M), (const bf16_t*)(p.ws + WS_BT2), MP, D, D};
      pg8::TailOrder S; S.init(D, bid, 8, 4);
      EpiRes E{(bf16_t*)(p.ws + WS_T1), (const bf16_t*)(p.ws + WS_XN), (bf16_t*)(p.ws + WS_PART)};
      pg8::gemm_phase<EpiRes, pg8::TailOrder, true, true>(lds, g, S, E);
    xcd_barrier(xb); }
    REP(6) { phase_ln1(p);
    xcd_barrier(xb); }
    REP(7) { pg8::Gemm g{(const bf16_t*)(p.ws + WS_H), (const bf16_t*)(p.ws + WS_BT3), MP, N3, D};
      pg8::StaticOrder S; S.init(MP, N3, D, G, bid);
      EpiSwiglu E{(bf16_t*)(p.ws + WS_ACT)};
      pg8::gemm_phase<EpiSwiglu, pg8::StaticOrder, true, true>(lds, g, S, E);
    xcd_barrier(xb); }
    REP(8) { pg8::Gemm g{(const bf16_t*)(p.ws + WS_ACT), (const bf16_t*)(p.ws + WS_BT4), MP, D, DFF};
      pg8::TailOrder S; S.init(DFF, bid, 11, 8);
      EpiRes E{(bf16_t*)(p.ws + WS_T2), (const bf16_t*)(p.ws + WS_H), (bf16_t*)(p.ws + WS_PART)};
      pg8::gemm_phase<EpiRes, pg8::TailOrder, true, true>(lds, g, S, E);
    xcd_barrier(xb); }
    REP(9) phase_ln2(p);
}

extern "C" void kernel_launch(void* const* d_in, const int* in_sizes, int n_in, void* d_out, int out_size, void* d_ws, size_t ws_size, hipStream_t stream) {
    constexpr size_t kDynLds = pg8::STAGE_BYTES + 16;
    static int grid_blocks = 0;
    if (!grid_blocks) {
        if (n_in != 19 || ws_size < WS_END) { fprintf(stderr, "kernel_launch: unexpected n_in %d / ws_size %zu (need %zu)\n", n_in, ws_size, (size_t)WS_END); grid_blocks = -1; return; }
        int dev = 0, cus = 0, per_cu = 0;
        hipGetDevice(&dev);
        hipDeviceGetAttribute(&cus, hipDeviceAttributeMultiprocessorCount, dev);
        hipFuncSetAttribute((const void*)fwd_megakernel, hipFuncAttributeMaxDynamicSharedMemorySize, (int)kDynLds);
        hipOccupancyMaxActiveBlocksPerMultiprocessor(&per_cu, (const void*)fwd_megakernel, 512, kDynLds);
        if (per_cu < 1) { fprintf(stderr, "kernel_launch: occupancy query says %d blocks/CU\n", per_cu); grid_blocks = -1; return; }
        if (cus != 256) { fprintf(stderr, "kernel_launch: built for 256 CUs, device has %d\n", cus); grid_blocks = -1; return; }
        grid_blocks = cus;
    }
    if (grid_blocks < 0) return;
    if (hipMemsetAsync((char*)d_ws + WS_BAR, 0, 16384, stream) != hipSuccess) { fprintf(stderr, "kernel_launch: memset of the barrier words failed\n"); return; }
    Params p{};
    for (int i = 0; i < 19; ++i) p.in[i] = (const float*)d_in[i];
    p.out = (float*)d_out; p.ws = (unsigned char*)d_ws;
    void* args[] = {&p};
    hipError_t e = hipLaunchCooperativeKernel((const void*)fwd_megakernel, dim3(grid_blocks), dim3(512), args, kDynLds, stream);
    if (e != hipSuccess) fprintf(stderr, "cooperative launch failed: %s (grid %d)\n", hipGetErrorString(e), grid_blocks);
}
```

```cpp
#include <hip/hip_runtime.h>
#include <hip/hip_cooperative_groups.h>
#include <cstdio>
#include <cstdint>
namespace cg = cooperative_groups;

#define LAS __attribute__((address_space(3)))
typedef unsigned short bf16_t;
typedef short bf16x8 __attribute__((ext_vector_type(8)));
typedef float f32x4 __attribute__((ext_vector_type(4)));
typedef float f32x2 __attribute__((ext_vector_type(2)));
typedef unsigned u32x4 __attribute__((ext_vector_type(4)));
typedef unsigned u32x2 __attribute__((ext_vector_type(2)));
typedef __bf16 bf16x2n __attribute__((ext_vector_type(2)));

__device__ __forceinline__ unsigned pk2(float lo, float hi) { f32x2 v = {lo, hi}; bf16x2n r = __builtin_convertvector(v, bf16x2n); return __builtin_bit_cast(unsigned, r); }
__device__ __forceinline__ float bf2f(unsigned b) { return __uint_as_float(b << 16); }
__device__ __forceinline__ float bflo(unsigned w) { return __uint_as_float(w << 16); }
__device__ __forceinline__ float bfhi(unsigned w) { return __uint_as_float(w & 0xffff0000u); }
__device__ __forceinline__ float wave_sum(float v) {
#pragma unroll
    for (int o = 1; o < 64; o <<= 1) v += __shfl_xor(v, o);
    return v;
}
#define LDS_WAIT() asm volatile("s_waitcnt lgkmcnt(0)" ::: "memory")
__device__ __forceinline__ int fresh_tid() { int t = threadIdx.x; asm volatile("" : "+v"(t)); return t; }

constexpr int D = 2048, MP = 8704, DFF = 5632;
constexpr int N1 = 16640, N3 = 2 * DFF;
constexpr int ROW_META = 48, ROW_PROMPT = 64, ROW_SAMPLE = 8256, ROW_END = 8512;
constexpr int NSLOT = 145, NITEM = NSLOT * 4;
constexpr float ALPHA = 1.189207115002721f;
constexpr float LN_EPS = 1e-5f, RMS_EPS = 1e-6f;
constexpr size_t WS_BT1 = 0;
constexpr size_t WS_BT2 = WS_BT1 + (size_t)N1 * D * 2;
constexpr size_t WS_BT3 = WS_BT2 + (size_t)D * D * 2;
constexpr size_t WS_BT4 = WS_BT3 + (size_t)N3 * D * 2;
constexpr size_t WS_XN = WS_BT4 + (size_t)D * DFF * 2;
constexpr size_t WS_UQKV = WS_XN + (size_t)MP * D * 2;
constexpr size_t WS_UREST = WS_UQKV + (size_t)MP * 4096 * 2;
constexpr size_t WS_A = WS_UREST + (size_t)MP * 12288 * 2;
constexpr size_t WS_VT = WS_A + (size_t)MP * 16 * 4;
constexpr size_t WS_BAR = WS_VT + (size_t)NITEM * 512 * 64 * 2;
constexpr size_t WS_ZERO = WS_BAR + 15360;
constexpr size_t WS_END = WS_BAR + 16384;
constexpr size_t WS_QT = WS_BT1;
constexpr size_t WS_KD = WS_QT + (size_t)NITEM * 64 * 256 * 2;
constexpr size_t WS_PM = WS_KD + (size_t)NITEM * 256 * 64 * 2;
constexpr size_t WS_DL = WS_PM + (size_t)NITEM * 64 * 64 * 2;
constexpr size_t WS_O = WS_UQKV;
constexpr size_t WS_M = WS_VT;
constexpr size_t WS_T1 = WS_UQKV;
constexpr size_t WS_H = WS_UREST;
constexpr size_t WS_ACT = WS_UREST + (size_t)MP * D * 2;
constexpr size_t WS_T2 = WS_UQKV;
constexpr size_t WS_PART = WS_BT1;
static_assert((size_t)16 * 512 * D * 4 <= (size_t)N1 * D * 2, "partials must fit in Bt1");
static_assert(WS_DL + (size_t)NITEM * 256 * 4 <= WS_BT2, "prep buffers must fit in Bt1");
static_assert((size_t)MP * D * 2 <= (size_t)NITEM * 512 * 64 * 2, "m must fit in VT");
constexpr size_t OUT_YP = 0;
constexpr size_t OUT_YS = OUT_YP + (size_t)8192 * D;
constexpr size_t OUT_SP = OUT_YS + (size_t)256 * D;
constexpr size_t OUT_CP = OUT_SP + (size_t)4 * 256 * 512;
constexpr size_t OUT_SS = OUT_CP + (size_t)2 * D;
constexpr size_t OUT_CS = OUT_SS + (size_t)16 * 4 * 256 * 512;

struct Params { const float* in[19]; float* out; unsigned char* ws; };

namespace pg8 {
#define PG8_LAS __attribute__((address_space(3)))
constexpr int BM = 256, BK = 64, HALF = 128, HTB = HALF * BK * 2, STAGE_BYTES = 8 * HTB, NXCD = 8, WGM = 4;
__host__ __device__ __forceinline__ int lds_byte(int r, int c) { const int st = (r >> 4) * 2 + (c >> 5), rr = r & 15, cc = c & 31, ob = rr * 64 + cc * 2; return st * 1024 + (ob ^ (((ob >> 9) & 1) << 5)); }
__host__ __device__ __forceinline__ void stage_rc(int b, int& R, int& C) { const int st = b / 1024, sb = b % 1024, swz = sb ^ (((sb >> 9) & 1) << 5); R = (st >> 1) * 16 + swz / 64; C = (st & 1) * 32 + (swz % 64) / 2; }
__host__ __device__ __forceinline__ int perm32(int rho) { const int n = rho >> 4, i = rho & 15; return 8 * (i >> 2) + 4 * n + (i & 3); }
struct Unit { int pm, pn, kt0, nt, part; };
struct Gemm { const bf16_t* A; const bf16_t* Bt; int M, N, K; };
struct StaticOrder {
    int nM, nN, nwg, G, c, knt;
    __host__ __device__ void init(int M, int N, int K, int G_, int c_) { nM = M / BM; nN = N / BM; nwg = nM * nN; G = G_; c = c_; knt = K / BK; }
    __host__ __device__ bool next(int i, Unit& u) const {
        const long L = (long)i * G + c; if (L >= nwg) return false;
        int wgid = (int)L; { const int q = nwg / NXCD, r = nwg % NXCD, xcd = wgid % NXCD, off = wgid / NXCD; wgid = (xcd < r ? xcd * (q + 1) : r * (q + 1) + (xcd - r) * q) + off; }
        const int nig = WGM * nN, gid = wgid / nig, fm = gid * WGM, gsz = (nM - fm) < WGM ? (nM - fm) : WGM;
        u.pm = fm + ((wgid % nig) % gsz); u.pn = (wgid % nig) / gsz; u.kt0 = 0; u.nt = knt; u.part = -1; return true;
    }
    __device__ __forceinline__ void a_ready(const Unit&) const {}
    __device__ __forceinline__ void done(const Unit&) const {}
};

struct TailOrder {
    int c, knt, P, ntp;
    __host__ __device__ void init(int K, int c_, int P_, int ntp_) { c = c_; knt = K / BK; P = P_; ntp = ntp_; }
    __host__ __device__ bool next(int i, Unit& u) const {
        if (i == 0) { u.pm = (c & 7) * 4 + ((c >> 3) & 3); u.pn = c >> 5; u.kt0 = 0; u.nt = knt; u.part = -1; return true; }
        if (i == 1 && c < 16 * P) { const int lu = c / P, part = c - lu * P; u.pm = 32 + (lu >> 3); u.pn = lu & 7; u.kt0 = part * ntp; u.nt = (knt - u.kt0) < ntp ? (knt - u.kt0) : ntp; u.part = part; return true; }
        return false;
    }
    __device__ __forceinline__ void a_ready(const Unit&) const {}
    __device__ __forceinline__ void done(const Unit&) const {}
};

template <class Epi, class Sched, bool ALIGN_EPI = false, bool SP2 = false>
__device__ __forceinline__ void gemm_phase(PG8_LAS unsigned char* lds, const Gemm g, const Sched& S, const Epi& E) {
    const int tid = threadIdx.x, wid = __builtin_amdgcn_readfirstlane(tid >> 6), lane = tid & 63, wr = wid >> 2, wc = wid & 3, fr = lane & 15, fq = lane >> 4;
    const int K = g.K;
    unsigned voffA[2], voffB[2];
#pragma unroll
    for (int i = 0; i < 2; ++i) { int R, C; stage_rc(tid * 16 + i * 8192, R, C); const int Rb = Epi::PERM ? ((R & ~31) + perm32(R & 31)) : R;
        voffA[i] = (unsigned)(R * K + C) * 2u; voffB[i] = (unsigned)(Rb * K + C) * 2u; }
    const size_t kstep = (size_t)(BK * 2);
    const size_t hstep = (size_t)HALF * K * 2;
    const size_t tstep = 2 * hstep;
    const unsigned ldsw = (unsigned)wid * 1024u;
    const int aoff = lds_byte(wr * 64 + fr, fq * 8), boff = lds_byte(wc * 32 + fr, fq * 8);
#define PG8_SA(b, h) (((b) * 2 + (h)) * HTB)
#define PG8_SB(b, h) ((4 + (b) * 2 + (h)) * HTB)
#define PG8_STAGE(bufoff, gbase, voff) do { _Pragma("unroll") for (int _i = 0; _i < 2; ++_i) \
        __builtin_amdgcn_global_load_lds((const unsigned*)((const char*)(gbase) + (voff)[_i]), (PG8_LAS unsigned*)(lds + (bufoff) + ldsw + _i * 8192), 16, 0, 0); } while (0)
#define PG8_LDA(dst, b, h) do { _Pragma("unroll") for (int m = 0; m < 4; ++m) _Pragma("unroll") for (int k = 0; k < 2; ++k) dst[m][k] = *(const PG8_LAS bf16x8*)(lds + PG8_SA(b, h) + aoff + m * 2048 + k * 1024); } while (0)
#define PG8_LDB(dst, b, h) do { _Pragma("unroll") for (int n = 0; n < 2; ++n) _Pragma("unroll") for (int k = 0; k < 2; ++k) dst[n][k] = *(const PG8_LAS bf16x8*)(lds + PG8_SB(b, h) + boff + n * 2048 + k * 1024); } while (0)
#define PG8_MMA(ai, bj, At, Bt) do { __builtin_amdgcn_s_setprio(1); _Pragma("unroll") for (int m = 0; m < 4; ++m) _Pragma("unroll") for (int n = 0; n < 2; ++n) _Pragma("unroll") for (int k = 0; k < 2; ++k) \
        acc[ai][bj][m][n] = __builtin_amdgcn_mfma_f32_16x16x32_bf16(Bt[n][k], At[m][k], acc[ai][bj][m][n], 0, 0, 0); __builtin_amdgcn_s_setprio(0); } while (0)
#define PG8_WAIT_V(n) asm volatile("s_waitcnt vmcnt(" #n ")" ::: "memory")
#define PG8_WAIT_L(n) asm volatile("s_waitcnt lgkmcnt(" #n ")" ::: "memory")
#define PG8_BAR __builtin_amdgcn_s_barrier()
#define PG8_SCHED __builtin_amdgcn_sched_barrier(0)
    Unit cur, nxt; int ui = 0;
    if (!S.next(0, cur)) return;
    f32x4 acc[2][2][4][2];
#pragma unroll
    for (int a = 0; a < 2; ++a)
#pragma unroll
        for (int b = 0; b < 2; ++b)
#pragma unroll
            for (int m = 0; m < 4; ++m)
#pragma unroll
                for (int n = 0; n < 2; ++n) acc[a][b][m][n] = (f32x4){0.f, 0.f, 0.f, 0.f};
    bf16x8 At[4][2], B0[2][2], B1[2][2];
    const char* cA = (const char*)g.A + (size_t)cur.pm * tstep + (size_t)cur.kt0 * kstep; const char* cB = (const char*)g.Bt + (size_t)cur.pn * tstep + (size_t)cur.kt0 * kstep;
    S.a_ready(cur);
    if constexpr (SP2) {
        PG8_STAGE(PG8_SB(0, 0), cB, voffB); PG8_STAGE(PG8_SB(0, 1), cB + hstep, voffB); PG8_STAGE(PG8_SA(0, 0), cA, voffA); PG8_STAGE(PG8_SA(0, 1), cA + hstep, voffA);
        if (wr == 1) PG8_BAR;
        PG8_WAIT_V(2); PG8_BAR;
        PG8_STAGE(PG8_SB(1, 0), cB + kstep, voffB); PG8_STAGE(PG8_SA(1, 0), cA + kstep, voffA); PG8_STAGE(PG8_SB(1, 1), cB + hstep + kstep, voffB);
        PG8_WAIT_V(6); PG8_BAR;
    } else {
        PG8_STAGE(PG8_SB(0, 0), cB, voffB); PG8_STAGE(PG8_SA(0, 0), cA, voffA); PG8_STAGE(PG8_SB(0, 1), cB + hstep, voffB); PG8_STAGE(PG8_SA(0, 1), cA + hstep, voffA);
        if (wr == 1) PG8_BAR;
        PG8_WAIT_V(4); PG8_BAR;
        PG8_STAGE(PG8_SB(1, 0), cB + kstep, voffB); PG8_STAGE(PG8_SA(1, 0), cA + kstep, voffA); PG8_STAGE(PG8_SB(1, 1), cB + hstep + kstep, voffB);
        PG8_WAIT_V(6); PG8_BAR;
    }
    for (;;) {
        const bool has_next = S.next(ui + 1, nxt);
        const char* nA = has_next ? (const char*)g.A + (size_t)nxt.pm * tstep + (size_t)nxt.kt0 * kstep : cA; const char* nB = has_next ? (const char*)g.Bt + (size_t)nxt.pn * tstep + (size_t)nxt.kt0 * kstep : cB;
        const int nt = cur.nt;
        for (int t = 0; t < nt; t += 2) {
            const bool last = (t == nt - 2);
            const char* a1 = cA + (size_t)(t + 1) * kstep;
            const char* a2 = last ? nA : cA + (size_t)(t + 2) * kstep; const char* b2 = last ? nB : cB + (size_t)(t + 2) * kstep;
            const char* a3 = a2 + kstep; const char* b3 = b2 + kstep;
            if (last && has_next) S.a_ready(nxt);
            if constexpr (SP2) {
            PG8_LDB(B0, 0, 0); PG8_LDB(B1, 0, 1); PG8_SCHED; PG8_LDA(At, 0, 0); PG8_STAGE(PG8_SA(1, 1), a1 + hstep, voffA);
            PG8_WAIT_V(8); PG8_WAIT_L(0); PG8_BAR; PG8_MMA(0, 0, At, B0); PG8_MMA(0, 1, At, B1); PG8_BAR; PG8_SCHED;
            PG8_LDA(At, 0, 1); PG8_STAGE(PG8_SB(0, 0), b2, voffB); PG8_STAGE(PG8_SB(0, 1), b2 + hstep, voffB); PG8_STAGE(PG8_SA(0, 0), a2, voffA);
            PG8_WAIT_V(8); PG8_WAIT_L(0); PG8_BAR; PG8_MMA(1, 0, At, B0); PG8_MMA(1, 1, At, B1); PG8_BAR; PG8_SCHED;
            PG8_LDB(B0, 1, 0); PG8_LDB(B1, 1, 1); PG8_SCHED; PG8_LDA(At, 1, 0); PG8_STAGE(PG8_SA(0, 1), a2 + hstep, voffA);
            PG8_WAIT_V(8); PG8_WAIT_L(0); PG8_BAR; PG8_MMA(0, 0, At, B0); PG8_MMA(0, 1, At, B1); PG8_BAR; PG8_SCHED;
            PG8_LDA(At, 1, 1); PG8_STAGE(PG8_SB(1, 0), b3, voffB); PG8_STAGE(PG8_SB(1, 1), b3 + hstep, voffB); PG8_STAGE(PG8_SA(1, 0), a3, voffA);
            PG8_WAIT_V(8); PG8_WAIT_L(0); PG8_BAR; PG8_MMA(1, 0, At, B0); PG8_MMA(1, 1, At, B1); PG8_BAR; PG8_SCHED;
            } else {
            PG8_LDB(B0, 0, 0); PG8_SCHED; PG8_LDA(At, 0, 0); PG8_STAGE(PG8_SA(1, 1), a1 + hstep, voffA);
            PG8_WAIT_L(8); PG8_BAR; PG8_WAIT_L(0); PG8_MMA(0, 0, At, B0); PG8_BAR; PG8_SCHED;
            PG8_LDB(B1, 0, 1); PG8_STAGE(PG8_SB(0, 0), b2, voffB);
            PG8_BAR; PG8_WAIT_L(0); PG8_MMA(0, 1, At, B1); PG8_BAR;
            PG8_LDA(At, 0, 1); PG8_STAGE(PG8_SA(0, 0), a2, voffA);
            PG8_BAR; PG8_WAIT_L(0); PG8_MMA(1, 0, At, B0); PG8_BAR; PG8_SCHED;
            PG8_STAGE(PG8_SB(0, 1), b2 + hstep, voffB);
            PG8_WAIT_V(6); PG8_BAR; PG8_MMA(1, 1, At, B1); PG8_BAR;
            PG8_LDB(B0, 1, 0); PG8_SCHED; PG8_LDA(At, 1, 0); PG8_STAGE(PG8_SA(0, 1), a2 + hstep, voffA);
            PG8_WAIT_L(8); PG8_BAR; PG8_WAIT_L(0); PG8_MMA(0, 0, At, B0); PG8_BAR; PG8_SCHED;
            PG8_LDB(B1, 1, 1); PG8_STAGE(PG8_SB(1, 0), b3, voffB);
            PG8_BAR; PG8_WAIT_L(0); PG8_MMA(0, 1, At, B1); PG8_BAR;
            PG8_LDA(At, 1, 1); PG8_STAGE(PG8_SA(1, 0), a3, voffA);
            PG8_BAR; PG8_WAIT_L(0); PG8_MMA(1, 0, At, B0); PG8_BAR; PG8_SCHED;
            PG8_STAGE(PG8_SB(1, 1), b3 + hstep, voffB);
            PG8_WAIT_V(6); PG8_BAR; PG8_MMA(1, 1, At, B1); PG8_BAR;
            }
        }
        if constexpr (ALIGN_EPI) { if (wr == 0) PG8_BAR; }
        E(acc, cur, wr, wc, fr, fq);
        if (!has_next) break;
#pragma unroll
        for (int a = 0; a < 2; ++a)
#pragma unroll
            for (int b = 0; b < 2; ++b)
#pragma unroll
                for (int m = 0; m < 4; ++m)
#pragma unroll
                    for (int n = 0; n < 2; ++n) acc[a][b][m][n] = (f32x4){0.f, 0.f, 0.f, 0.f};
        cur = nxt; cA = nA; cB = nB; ++ui;
        if constexpr (ALIGN_EPI) { if (wr == 1) PG8_BAR; }
    }
    PG8_WAIT_V(0);
    if constexpr (!ALIGN_EPI) { if (wr == 0) PG8_BAR; }
    PG8_BAR;
#undef PG8_SA
#undef PG8_SB
#undef PG8_STAGE
#undef PG8_LDA
#undef PG8_LDB
#undef PG8_MMA
#undef PG8_WAIT_V
#undef PG8_WAIT_L
#undef PG8_BAR
#undef PG8_SCHED
}
}

struct EpiU {
    static constexpr bool PERM = true;
    bf16_t* Uqkv; bf16_t* Urest; float* Abuf;
    __device__ __forceinline__ void operator()(const f32x4 (&acc)[2][2][4][2], const pg8::Unit& u, int wr, int wc, int fr, int fq) const {
        const int row0 = u.pm * 256 + wr * 64 + fr;
        if (u.pn == 64) {
            if (wc == 0 && fq < 2) {
#pragma unroll
                for (int ai = 0; ai < 2; ++ai)
#pragma unroll
                    for (int m = 0; m < 4; ++m) { float* rp = Abuf + (size_t)(row0 + ai * 128 + m * 16) * 16 + 8 * fq;
                        *(f32x4*)(rp) = acc[ai][0][m][0]; *(f32x4*)(rp + 4) = acc[ai][0][m][1]; }
            }
        } else if (u.pn >= 16) {
            const int grp = (u.pn - 16) >> 4;
            const int col0 = grp * 2048 + ((u.pn - 16) & 15) * 128 + wc * 32 + 8 * fq;
#pragma unroll
            for (int ai = 0; ai < 2; ++ai)
#pragma unroll
                for (int m = 0; m < 4; ++m) { bf16_t* rp = Urest + (size_t)(row0 + ai * 128 + m * 16) * 6144 + col0;
                    float r[8];
#pragma unroll
                    for (int n = 0; n < 2; ++n)
#pragma unroll
                        for (int j = 0; j < 4; ++j) { const float a0 = acc[ai][0][m][n][j], a1 = acc[ai][1][m][n][j];
                            float v = a0 * a1;
                            if (grp != 1) { v = a0 * __builtin_amdgcn_rcpf(1.f + __expf(-a1)); if (grp == 0) v *= __builtin_amdgcn_rcpf(1.f + __expf(-a0)); }
                            r[n * 4 + j] = v; }
                    u32x4 o; o.x = pk2(r[0], r[1]); o.y = pk2(r[2], r[3]); o.z = pk2(r[4], r[5]); o.w = pk2(r[6], r[7]);
                    __builtin_nontemporal_store(o, (u32x4*)rp); }
        } else {
            const int col0 = u.pn * 256 + wc * 32 + 8 * fq;
#pragma unroll
            for (int ai = 0; ai < 2; ++ai)
#pragma unroll
                for (int m = 0; m < 4; ++m) { bf16_t* rp = Uqkv + (size_t)(row0 + ai * 128 + m * 16) * 4096 + col0;
#pragma unroll
                    for (int bj = 0; bj < 2; ++bj) { const f32x4 v0 = acc[ai][bj][m][0], v1 = acc[ai][bj][m][1];
                        u32x4 o; o.x = pk2(v0[0], v0[1]); o.y = pk2(v0[2], v0[3]); o.z = pk2(v1[0], v1[1]); o.w = pk2(v1[2], v1[3]);
                        *(u32x4*)(rp + bj * 128) = o; } }
        }
    }
};
struct EpiRes {
    static constexpr bool PERM = false;
    bf16_t* C; const bf16_t* R; bf16_t* Part;
    __device__ __forceinline__ void operator()(const f32x4 (&acc)[2][2][4][2], const pg8::Unit& u, int wr, int wc, int fr, int fq) const {
        const int row0 = u.pm * 256 + wr * 64 + fr, col0 = u.pn * 256 + wc * 32 + 4 * fq;
        if (u.part >= 0) {
            bf16_t* P = Part + (size_t)u.part * 512 * D;
#pragma unroll
            for (int ai = 0; ai < 2; ++ai)
#pragma unroll
                for (int m = 0; m < 4; ++m) { const size_t ro = (size_t)(row0 + ai * 128 + m * 16 - 8192) * D + col0;
#pragma unroll
                    for (int bj = 0; bj < 2; ++bj)
#pragma unroll
                        for (int n = 0; n < 2; ++n) { const f32x4 v = acc[ai][bj][m][n]; *(u32x2*)(P + ro + bj * 128 + n * 16) = (u32x2){pk2(v[0], v[1]), pk2(v[2], v[3])}; } }
            return;
        }
#pragma unroll
        for (int ai = 0; ai < 2; ++ai)
#pragma unroll
            for (int m = 0; m < 4; ++m) { const size_t ro = (size_t)(row0 + ai * 128 + m * 16) * D + col0;
#pragma unroll
                for (int bj = 0; bj < 2; ++bj)
#pragma unroll
                    for (int n = 0; n < 2; ++n) { const u32x2 rr = *(const u32x2*)(R + ro + bj * 128 + n * 16);
                        f32x4 v = acc[ai][bj][m][n];
                        v[0] += ALPHA * bflo(rr.x); v[1] += ALPHA * bfhi(rr.x); v[2] += ALPHA * bflo(rr.y); v[3] += ALPHA * bfhi(rr.y);
                        *(u32x2*)(C + ro + bj * 128 + n * 16) = (u32x2){pk2(v[0], v[1]), pk2(v[2], v[3])}; } }
    }
};
struct EpiSwiglu {
    static constexpr bool PERM = true;
    bf16_t* O;
    __device__ __forceinline__ void operator()(const f32x4 (&acc)[2][2][4][2], const pg8::Unit& u, int wr, int wc, int fr, int fq) const {
        const int row0 = u.pm * 256 + wr * 64 + fr, col0 = u.pn * 128 + wc * 32 + 8 * fq;
#pragma unroll
        for (int ai = 0; ai < 2; ++ai)
#pragma unroll
            for (int m = 0; m < 4; ++m) { bf16_t* rp = O + (size_t)(row0 + ai * 128 + m * 16) * DFF + col0;
                float r[8];
#pragma unroll
                for (int n = 0; n < 2; ++n)
#pragma unroll
                    for (int j = 0; j < 4; ++j) { const float gt = acc[ai][0][m][n][j], up = acc[ai][1][m][n][j];
                        r[n * 4 + j] = gt * up * __builtin_amdgcn_rcpf(1.f + __expf(-gt)); }
                u32x4 o; o.x = pk2(r[0], r[1]); o.y = pk2(r[2], r[3]); o.z = pk2(r[4], r[5]); o.w = pk2(r[6], r[7]);
                *(u32x4*)(rp) = o; }
    }
};

template <int NB, bool NTS = false> __device__ __forceinline__ void tr_item(const float* W, int ldw, int k0, int srcc0, int nvalid, bf16_t* WT, int K, int drow0, LAS unsigned* scr, int lane) {
    const int cq = (lane & 15) * 4, kq = lane >> 4;
    const float* src0 = W + (size_t)(k0 + 2 * kq) * ldw + srcc0 + cq;
#pragma unroll
    for (int hh = 0; hh < 8 / NB; ++hh) {
        f32x4 a[NB], b[NB];
#pragma unroll
        for (int ii = 0; ii < NB; ++ii) { a[ii] = (f32x4){0.f, 0.f, 0.f, 0.f}; b[ii] = a[ii];
            if (cq < nvalid) { const float* src = src0 + (size_t)(8 * (NB * hh + ii)) * ldw; a[ii] = __builtin_nontemporal_load((const f32x4*)src); b[ii] = __builtin_nontemporal_load((const f32x4*)(src + ldw)); } }
#pragma unroll
        for (int ii = 0; ii < NB; ++ii) { const int kp = 4 * (NB * hh + ii) + kq; LAS unsigned* d = scr + kp * 65 + cq;
            d[0] = pk2(a[ii][0], b[ii][0]); d[1] = pk2(a[ii][1], b[ii][1]); d[2] = pk2(a[ii][2], b[ii][2]); d[3] = pk2(a[ii][3], b[ii][3]); }
    }
    LDS_WAIT();
    const int c = lane & 7;
#pragma unroll
    for (int j = 0; j < 8; ++j) { const int n = (lane >> 3) + 8 * j; const LAS unsigned* sp = scr + (4 * c) * 65 + n;
        u32x4 o; o.x = sp[0]; o.y = sp[65]; o.z = sp[130]; o.w = sp[195];
        if constexpr (NTS) __builtin_nontemporal_store(o, (u32x4*)(WT + (size_t)(drow0 + n) * K + k0 + 8 * c)); else *(u32x4*)(WT + (size_t)(drow0 + n) * K + k0 + 8 * c) = o; }
    LDS_WAIT();
}
__device__ __forceinline__ void ln_norm(const float* g, const float* b, int lane, f32x4 (&v)[8]) {
    float s = 0.f;
#pragma unroll
    for (int j = 0; j < 8; ++j) s += (v[j][0] + v[j][1]) + (v[j][2] + v[j][3]);
    const float mean = wave_sum(s) * (1.f / D); float s2 = 0.f;
#pragma unroll
    for (int j = 0; j < 8; ++j) { v[j] = v[j] - mean; s2 += (v[j][0] * v[j][0] + v[j][1] * v[j][1]) + (v[j][2] * v[j][2] + v[j][3] * v[j][3]); }
    const float rstd = 1.f / sqrtf(wave_sum(s2) * (1.f / D) + LN_EPS);
#pragma unroll
    for (int j = 0; j < 8; ++j) { const f32x4 gg = *(const f32x4*)(g + 4 * lane + 256 * j), bb = *(const f32x4*)(b + 4 * lane + 256 * j); v[j] = v[j] * rstd * gg + bb; }
}
__device__ __forceinline__ void ln_row(const bf16_t* xrow, const float* g, const float* b, int lane, f32x4 (&v)[8]) {
#pragma unroll
    for (int j = 0; j < 8; ++j) { const u32x2 w = __builtin_nontemporal_load((const u32x2*)(xrow + 4 * lane + 256 * j)); v[j] = (f32x4){bflo(w.x), bfhi(w.x), bflo(w.y), bfhi(w.y)}; }
    ln_norm(g, b, lane, v);
}
__device__ __forceinline__ void ln_row_tail(const bf16_t* part, int nparts, int row, const bf16_t* res, const float* g, const float* b, int lane, f32x4 (&v)[8]) {
#pragma unroll
    for (int j = 0; j < 8; ++j) { const u32x2 rr = *(const u32x2*)(res + (size_t)row * D + 4 * lane + 256 * j);
        v[j] = (f32x4){ALPHA * bflo(rr.x), ALPHA * bfhi(rr.x), ALPHA * bflo(rr.y), ALPHA * bfhi(rr.y)}; }
    int pp = 0;
    for (; pp + 1 < nparts; pp += 2) { const bf16_t* pr = part + ((size_t)pp * 512 + (row - 8192)) * D + 4 * lane; const bf16_t* pr2 = pr + (size_t)512 * D;
        u32x2 a[8], b[8];
#pragma unroll
        for (int j = 0; j < 8; ++j) { a[j] = __builtin_nontemporal_load((const u32x2*)(pr + 256 * j)); b[j] = __builtin_nontemporal_load((const u32x2*)(pr2 + 256 * j)); }
#pragma unroll
        for (int j = 0; j < 8; ++j) v[j] += (f32x4){bflo(a[j].x) + bflo(b[j].x), bfhi(a[j].x) + bfhi(b[j].x), bflo(a[j].y) + bflo(b[j].y), bfhi(a[j].y) + bfhi(b[j].y)}; }
    if (pp < nparts) { const bf16_t* pr = part + ((size_t)pp * 512 + (row - 8192)) * D + 4 * lane;
#pragma unroll
        for (int j = 0; j < 8; ++j) { const u32x2 a = *(const u32x2*)(pr + 256 * j); v[j] += (f32x4){bflo(a.x), bfhi(a.x), bflo(a.y), bfhi(a.y)}; } }
    ln_norm(g, b, lane, v);
}
__device__ __forceinline__ void store_row_bf16(bf16_t* orow, int lane, const f32x4 (&v)[8]) {
#pragma unroll
    for (int j = 0; j < 8; ++j) { u32x2 o; o.x = pk2(v[j][0], v[j][1]); o.y = pk2(v[j][2], v[j][3]); *(u32x2*)(orow + 4 * lane + 256 * j) = o; }
}

template <int NB> __device__ __forceinline__ void transposes(const Params& p, LAS unsigned char* lds, int it_lo, int it_hi, int gw, int NGW, int w, int lane) {
    LAS unsigned* scr = (LAS unsigned*)(lds + w * 8448);
    bf16_t* Bt1 = (bf16_t*)(p.ws + WS_BT1); bf16_t* Bt2 = (bf16_t*)(p.ws + WS_BT2); bf16_t* Bt3 = (bf16_t*)(p.ws + WS_BT3); bf16_t* Bt4 = (bf16_t*)(p.ws + WS_BT4);
    constexpr int NB1 = N1 / 64, NB2 = D / 64, NB3 = N3 / 64, NB4 = D / 64;
    constexpr int I1 = 32 * NB1, I2 = 32 * NB2, I3 = 32 * NB3;
    for (int it = it_lo + gw; it < it_hi; it += NGW) {
        int r = it;
        if (r < I1) { const int kb = r / NB1, n0 = (r % NB1) * 64; int src, nv;
            if (n0 < 4096) { src = n0; nv = 64; }
            else if (n0 < 16384) {
                const int grp = (n0 - 4096) >> 12, rel = (n0 - 4096) & 4095, hf = (rel >> 7) & 1;
                const int base = grp == 0 ? (hf ? 12304 : 4096) : (grp == 1 ? (hf ? 10256 : 8208) : (hf ? 14352 : 6160));
                src = base + (rel >> 8) * 128 + (rel & 127); nv = 64; }
            else if (n0 == 16384) { src = 6144; nv = 16; } else { src = 0; nv = 0; }
            tr_item<NB>(p.in[7], 16400, kb * 64, src, nv, Bt1, D, n0, scr, lane); continue; }
        r -= I1;
        if (r < I2) { const int kb = r / NB2, n0 = (r % NB2) * 64; tr_item<NB, true>(p.in[12], D, kb * 64, n0, 64, Bt2, D, n0, scr, lane); continue; }
        r -= I2;
        if (r < I3) { const int kb = r / NB3, n0 = (r % NB3) * 64; const int src = ((n0 >> 7) & 1) * DFF + (n0 >> 8) * 128 + (n0 & 127);
            tr_item<NB, true>(p.in[15], N3, kb * 64, src, 64, Bt3, D, n0, scr, lane); continue; }
        r -= I3;
        { const int kb = r / NB4, n0 = (r % NB4) * 64; tr_item<NB, true>(p.in[16], D, kb * 64, n0, 64, Bt4, DFF, n0, scr, lane); }
    }
}
constexpr int TR_I1 = 32 * (N1 / 64), TR_ALL = TR_I1 + 32 * (D / 64) + 32 * (N3 / 64) + (DFF / 64) * (D / 64);
constexpr int TR_SPLIT = TR_ALL;
constexpr int TR_IDLE = 3760;
__device__ __forceinline__ void phase0(const Params& p, LAS unsigned char* lds) {
    const int tid_ = fresh_tid(); const int lane = tid_ & 63, w = tid_ >> 6;
    const int gw = blockIdx.x * 8 + w, NGW = gridDim.x * 8;
    transposes<8>(p, lds, 0, TR_ALL - TR_IDLE, gw, NGW, w, lane);
    bf16_t* XN = (bf16_t*)(p.ws + WS_XN);
    for (int row = gw; row < MP; row += NGW) {
        bf16_t* orow = XN + (size_t)row * D;
        if (row < ROW_META || row >= ROW_END) {
#pragma unroll
            for (int j = 0; j < 8; ++j) *(u32x2*)(orow + 4 * lane + 256 * j) = (u32x2){0u, 0u};
            continue;
        }
        const float* xr = row < ROW_PROMPT ? p.in[4] + (size_t)(row - ROW_META) * D : (row < ROW_SAMPLE ? p.in[0] + (size_t)(row - ROW_PROMPT) * D : p.in[1] + (size_t)(row - ROW_SAMPLE) * D);
        f32x4 v[8];
#pragma unroll
        for (int j = 0; j < 8; ++j) v[j] = __builtin_nontemporal_load((const f32x4*)(xr + 4 * lane + 256 * j));
        ln_norm(p.in[5], p.in[6], lane, v); store_row_bf16(orow, lane, v);
    }
}

__device__ __forceinline__ float logsigmoid(float z) { return fminf(z, 0.f) - __logf(1.f + __expf(-fabsf(z))); }
__device__ __forceinline__ void gla_prep_item(const Params& p, LAS unsigned char* lds, int it) {
    const int tid = threadIdx.x, lane = tid & 63, w = tid >> 6, l15 = lane & 15, quad = lane >> 4;
    const int slot = it >> 2, h = it & 3;
    const int row0 = slot == 0 ? ROW_META : (slot < 129 ? slot * 64 : ROW_SAMPLE + (slot - 129) * 16);
    const int ntok = (slot == 0 || slot >= 129) ? 16 : 64;
    const float* Abuf = (const float*)(p.ws + WS_A);
    const bf16_t* Uqkv = (const bf16_t*)(p.ws + WS_UQKV);
    bf16_t* QT = (bf16_t*)(p.ws + WS_QT); bf16_t* KD = (bf16_t*)(p.ws + WS_KD); bf16_t* PM = (bf16_t*)(p.ws + WS_PM); float* DL = (float*)(p.ws + WS_DL); bf16_t* VT = (bf16_t*)(p.ws + WS_VT);
    LAS float* sA = (LAS float*)lds;
    LAS float* sTot = (LAS float*)(lds + 4096);
    LAS unsigned char* sQ = lds + 8192;
    LAS unsigned char* sK = lds + 8192 + 33792;
    if (tid < 256) { const int tok = tid >> 2, c4 = (tid & 3) * 4; f32x4 v = {0.f, 0.f, 0.f, 0.f};
        if (tok < ntok) v = *(const f32x4*)(Abuf + (size_t)(row0 + tok) * 16 + c4);
        *(LAS f32x4*)(sA + tok * 16 + c4) = v; }
#pragma unroll
    for (int j = 0; j < 8; ++j) { const int c = tid + 512 * j, isk = c >> 11, tok = (c >> 5) & 63, cc = c & 31;
        u32x4 v = {0u, 0u, 0u, 0u};
        if (tok < ntok) v = __builtin_nontemporal_load((const u32x4*)(Uqkv + (size_t)(row0 + tok) * 4096 + isk * 1024 + h * 256 + cc * 8));
        *(LAS u32x4*)((isk ? sK : sQ) + tok * 528 + cc * 16) = v; }
    __syncthreads();
    const int d = tid & 255, half = tid >> 8;
    float wg[16];
#pragma unroll
    for (int r = 0; r < 16; ++r) wg[r] = p.in[8][r * 1024 + h * 256 + d];
    const float bg = p.in[9][h * 256 + d];
    float bb[32]; float run = 0.f;
#pragma unroll
    for (int i = 0; i < 32; ++i) { const int tok = half * 32 + i;
        const f32x4 a0 = *(const LAS f32x4*)(sA + tok * 16), a1 = *(const LAS f32x4*)(sA + tok * 16 + 4), a2 = *(const LAS f32x4*)(sA + tok * 16 + 8), a3 = *(const LAS f32x4*)(sA + tok * 16 + 12);
        float z = bg;
        z += a0[0] * wg[0] + a0[1] * wg[1] + a0[2] * wg[2] + a0[3] * wg[3];
        z += a1[0] * wg[4] + a1[1] * wg[5] + a1[2] * wg[6] + a1[3] * wg[7];
        z += a2[0] * wg[8] + a2[1] * wg[9] + a2[2] * wg[10] + a2[3] * wg[11];
        z += a3[0] * wg[12] + a3[1] * wg[13] + a3[2] * wg[14] + a3[3] * wg[15];
        float g = logsigmoid(z) * (1.f / 16.f);
        if (tok >= ntok) g = 0.f;
        run += g; bb[i] = run; }
    sTot[half * 256 + d] = run;
    __syncthreads();
    const float t0 = sTot[d], t1 = sTot[256 + d];
    const float off = half ? t0 : 0.f, blast = t0 + t1;
    if (half == 0) DL[(size_t)it * 256 + d] = __expf(blast);
    const int dl5 = d & 31;
    const int pos = (d & ~31) + ((dl5 < 16) ? ((dl5 >> 2) * 8 + (dl5 & 3)) : (((dl5 - 16) >> 2) * 8 + 4 + (dl5 & 3)));
    unsigned kdp[16];
    const float eblast = __expf(blast);
#pragma unroll
    for (int i = 0; i < 32; i += 2) { const int tok = half * 32 + i;
        const float q0 = bf2f(*(const LAS bf16_t*)(sQ + tok * 528 + d * 2)), q1 = bf2f(*(const LAS bf16_t*)(sQ + (tok + 1) * 528 + d * 2));
        const float k0 = bf2f(*(const LAS bf16_t*)(sK + tok * 528 + d * 2)), k1 = bf2f(*(const LAS bf16_t*)(sK + (tok + 1) * 528 + d * 2));
        const float e0 = __expf(off + bb[i]), e1 = __expf(off + bb[i + 1]);
        const float r0 = __builtin_amdgcn_rcpf(e0), r1 = __builtin_amdgcn_rcpf(e1);
        const float kt0 = k0 * r0, kt1 = k1 * r1;
        const unsigned qq = pk2(q0 * 0.0625f * e0, q1 * 0.0625f * e1);
        const unsigned kk = pk2(kt0, kt1);
        asm volatile("s_waitcnt lgkmcnt(0)" ::: "memory");
        *(LAS bf16_t*)(sQ + tok * 528 + pos * 2) = (bf16_t)(qq & 0xffffu); *(LAS bf16_t*)(sQ + (tok + 1) * 528 + pos * 2) = (bf16_t)(qq >> 16);
        *(LAS bf16_t*)(sK + tok * 528 + pos * 2) = (bf16_t)(kk & 0xffffu); *(LAS bf16_t*)(sK + (tok + 1) * 528 + pos * 2) = (bf16_t)(kk >> 16);
        kdp[i >> 1] = pk2(kt0 * eblast, kt1 * eblast); }
    {
      bf16_t* kr = KD + (size_t)it * 16384 + (size_t)((((d >> 5) * 2 + ((d >> 4) & 1)) * 2 + half) * 64 + (d & 15)) * 8;
#pragma unroll
      for (int j = 0; j < 4; ++j) *(u32x4*)(kr + j * 128) = (u32x4){kdp[4 * j], kdp[4 * j + 1], kdp[4 * j + 2], kdp[4 * j + 3]}; }
    __syncthreads();
#pragma unroll
    for (int j = 0; j < 4; ++j) { const int c = tid + 512 * j, ln = c & 63, tt = (c >> 6) & 3, ww = c >> 8;
        *(u32x4*)(QT + (size_t)it * 16384 + (size_t)c * 8) = *(const LAS u32x4*)(sQ + (tt * 16 + (ln & 15)) * 528 + (32 * ww + (ln >> 4) * 8) * 2); }
#pragma unroll
    for (int e = 0; e < 2; ++e) { const int id = 2 * w + e, ti = id >> 2, tj = id & 3;
        f32x4 acc = {0.f, 0.f, 0.f, 0.f};
        if (tj <= ti) {
#pragma unroll
            for (int ks = 0; ks < 8; ++ks) { const bf16x8 A = *(const LAS bf16x8*)(sK + (tj * 16 + l15) * 528 + ks * 64 + quad * 16), B = *(const LAS bf16x8*)(sQ + (ti * 16 + l15) * 528 + ks * 64 + quad * 16);
                acc = __builtin_amdgcn_mfma_f32_16x16x32_bf16(A, B, acc, 0, 0, 0); }
        }
        const int i = ti * 16 + l15, j0 = tj * 16 + quad * 4;
#pragma unroll
        for (int r = 0; r < 4; ++r) if (j0 + r > i) acc[r] = 0.f;
        *(u32x2*)(PM + (size_t)it * 4096 + (size_t)(((ti * 2 + (tj >> 1)) * 64 + ((tj & 1) * 2 + (quad >> 1)) * 16 + l15) * 8 + (quad & 1) * 4)) = (u32x2){pk2(acc[0], acc[1]), pk2(acc[2], acc[3])}; }
#pragma unroll
    for (int ps = 0; ps < 2; ++ps) { const int c = ps * 256 + d; unsigned vp[16];
#pragma unroll
        for (int i = 0; i < 32; i += 2) { const int tok = half * 32 + i; unsigned v0 = 0, v1 = 0;
            if (tok < ntok) { const bf16_t* ur = Uqkv + (size_t)(row0 + tok) * 4096 + 2048 + h * 512 + c; v0 = __builtin_nontemporal_load(ur); v1 = __builtin_nontemporal_load(ur + 4096); }
            vp[i >> 1] = v0 | (v1 << 16); }
        bf16_t* vr = VT + (size_t)it * 32768 + (size_t)(((c >> 4) * 2 + half) * 64 + (c & 15)) * 8;
#pragma unroll
        for (int j = 0; j < 4; ++j) *(u32x4*)(vr + j * 128) = (u32x4){vp[4 * j], vp[4 * j + 1], vp[4 * j + 2], vp[4 * j + 3]}; }
    __syncthreads();
}

struct ScanOps { bf16x8 q[4]; bf16x8 kd[2][2]; bf16x8 v[2]; bf16x8 pp[2]; f32x4 dl[2]; };
__device__ __forceinline__ void scan_load(const Params& p, ScanOps& o, int it, int kw, int vt16, int khalf, int kq, int l15, int quad) {
    const bf16_t* QT = (const bf16_t*)(p.ws + WS_QT); const bf16_t* KD = (const bf16_t*)(p.ws + WS_KD); const bf16_t* PM = (const bf16_t*)(p.ws + WS_PM);
    const float* DL = (const float*)(p.ws + WS_DL); const bf16_t* VT = (const bf16_t*)(p.ws + WS_VT);
    const int lane = quad * 16 + l15;
#pragma unroll
    for (int tt = 0; tt < 4; ++tt) o.q[tt] = *(const bf16x8*)(QT + (size_t)it * 16384 + (size_t)((kw * 4 + tt) * 64 + lane) * 8);
#pragma unroll
    for (int t = 0; t < 2; ++t)
#pragma unroll
        for (int ks = 0; ks < 2; ++ks) o.kd[t][ks] = *(const bf16x8*)(KD + (size_t)it * 16384 + (size_t)(((kw * 2 + t) * 2 + ks) * 64 + lane) * 8);
#pragma unroll
    for (int ks = 0; ks < 2; ++ks) o.v[ks] = *(const bf16x8*)(VT + (size_t)it * 32768 + (size_t)((vt16 * 2 + ks) * 64 + lane) * 8);
    const bf16_t* pbase = khalf == 0 ? PM + (size_t)it * 4096 + (size_t)(kq * 2 * 64) * 8 : (const bf16_t*)(p.ws + WS_ZERO) - (size_t)0;
#pragma unroll
    for (int ks = 0; ks < 2; ++ks) o.pp[ks] = *(const bf16x8*)(pbase + (khalf == 0 ? (size_t)(ks * 64 + lane) * 8 : (size_t)(lane & 31) * 8));
#pragma unroll
    for (int t = 0; t < 2; ++t) o.dl[t] = *(const f32x4*)(DL + (size_t)it * 256 + 32 * kw + 16 * t + quad * 4);
}
__device__ __forceinline__ void gla_step(LAS float* red, const ScanOps& cur, f32x4 (&S)[2], int kq, int lane, int& step) {
    const int buf = step & 1; ++step;
    u32x4 sp; sp.x = pk2(S[0][0], S[0][1]); sp.y = pk2(S[0][2], S[0][3]); sp.z = pk2(S[1][0], S[1][1]); sp.w = pk2(S[1][2], S[1][3]);
    const bf16x8 Sb = __builtin_bit_cast(bf16x8, sp);
    f32x4 ao[4];
#pragma unroll
    for (int tt = 0; tt < 4; ++tt) ao[tt] = __builtin_amdgcn_mfma_f32_16x16x32_bf16(cur.q[tt], Sb, (f32x4){0.f, 0.f, 0.f, 0.f}, 0, 0, 0);
    f32x4 ai = {0.f, 0.f, 0.f, 0.f};
#pragma unroll
    for (int ks = 0; ks < 2; ++ks) ai = __builtin_amdgcn_mfma_f32_16x16x32_bf16(cur.pp[ks], cur.v[ks], ai, 0, 0, 0);
    LAS float* rw = red + (buf * 6 + kq) * 1024 + lane * 4;
#pragma unroll
    for (int tt = 0; tt < 4; ++tt) *(LAS f32x4*)(rw + tt * 256) = ao[tt];
    *(LAS f32x4*)(red + (buf * 6 + 4) * 1024 + (kq * 64 + lane) * 4) = ai;
    asm volatile("s_waitcnt lgkmcnt(0)" ::: "memory"); __builtin_amdgcn_s_barrier(); asm volatile("" ::: "memory");
#pragma unroll
    for (int t = 0; t < 2; ++t) { f32x4 u = {0.f, 0.f, 0.f, 0.f};
#pragma unroll
        for (int ks = 0; ks < 2; ++ks) u = __builtin_amdgcn_mfma_f32_16x16x32_bf16(cur.kd[t][ks], cur.v[ks], u, 0, 0, 0);
        S[t] = cur.dl[t] * S[t] + u; }
}
__device__ __forceinline__ void gla_consume(const Params& p, LAS float* red, int c, int slot, int h, int khalf, int vs16, int& step) {
    const int buf = step & 1; ++step;
    asm volatile("" ::: "memory"); __builtin_amdgcn_s_barrier(); asm volatile("" ::: "memory");
    bf16_t* O = (bf16_t*)(p.ws + WS_O) + (size_t)khalf * MP * D;
    f32x4 sum = *(const LAS f32x4*)(red + (buf * 6 + 4) * 1024 + c * 4);
#pragma unroll
    for (int k4 = 0; k4 < 4; ++k4) sum += *(const LAS f32x4*)(red + (buf * 6 + k4) * 1024 + c * 4);
    const int tt = c >> 6, ln = c & 63, tok0 = 16 * tt + (ln >> 4) * 4;
    const int ntok = (slot == 0 || slot >= 129) ? 16 : 64, row0 = slot == 0 ? ROW_META : (slot < 129 ? slot * 64 : ROW_SAMPLE + (slot - 129) * 16);
    const int rowb = tok0 < ntok ? row0 + tok0 : ROW_END + tok0;
    bf16_t* op = O + (size_t)rowb * D + h * 512 + vs16 * 16 + (ln & 15);
    const unsigned w01 = pk2(sum[0], sum[1]), w23 = pk2(sum[2], sum[3]);
    op[0] = (bf16_t)(w01 & 0xffffu); op[D] = (bf16_t)(w01 >> 16); op[2 * D] = (bf16_t)(w23 & 0xffffu); op[3 * D] = (bf16_t)(w23 >> 16);
}
__device__ __forceinline__ void gla_chain(const Params& p, LAS unsigned char* lds, int slot0, int nslots, int h, int khalf, int vs16, float* Sout, int& step) {
    const int tid = fresh_tid(), lane = tid & 63, w = __builtin_amdgcn_readfirstlane(tid >> 6), l15 = lane & 15, quad = lane >> 4;
    LAS float* red = (LAS float*)lds;
    if (w >= 4) { for (int s = 0; s < nslots; ++s) gla_consume(p, red, tid - 256, slot0 + s, h, khalf, vs16, step); return; }
    const int kq = w, kw = khalf * 4 + kq;
    f32x4 S[2];
#pragma unroll
    for (int t = 0; t < 2; ++t) S[t] = (f32x4){0.f, 0.f, 0.f, 0.f};
    const int last = slot0 + nslots - 1;
    ScanOps A, B;
    scan_load(p, A, slot0 * 4 + h, kw, vs16, khalf, kq, l15, quad);
    int s = 0;
    for (; s + 1 < nslots; s += 2) {
        scan_load(p, B, (slot0 + s + 1) * 4 + h, kw, vs16, khalf, kq, l15, quad);
        gla_step(red, A, S, kq, lane, step);
        { const int sn = slot0 + s + 2 < last ? slot0 + s + 2 : last; scan_load(p, A, sn * 4 + h, kw, vs16, khalf, kq, l15, quad); }
        gla_step(red, B, S, kq, lane, step);
    }
    if (s < nslots) gla_step(red, A, S, kq, lane, step);
#pragma unroll
    for (int t = 0; t < 2; ++t)
#pragma unroll
        for (int r = 0; r < 4; ++r) Sout[(size_t)(32 * kw + 16 * t + quad * 4 + r) * 512 + vs16 * 16 + l15] = S[t][r];
}

struct SampItem { int slot, h, khalf, vs16, sh; };
__device__ __forceinline__ SampItem samp_decode(int i2) { SampItem m; m.sh = i2 >> 6; m.slot = 129 + (m.sh >> 2); m.h = m.sh & 3; m.khalf = (i2 >> 5) & 1; m.vs16 = i2 & 31; return m; }
__device__ __forceinline__ void samp_load(const Params& p, const SampItem& m, ScanOps& o, f32x4 (&S)[2], int kq, int l15, int quad) {
    const int kw = m.khalf * 4 + kq;
    scan_load(p, o, m.slot * 4 + m.h, kw, m.vs16, m.khalf, kq, l15, quad);
    const float* S0 = p.in[2] + (size_t)m.sh * 256 * 512 + (size_t)(32 * kw + quad * 4) * 512 + m.vs16 * 16 + l15;
#pragma unroll
    for (int t = 0; t < 2; ++t)
#pragma unroll
        for (int r = 0; r < 4; ++r) S[t][r] = __builtin_nontemporal_load(S0 + (size_t)(16 * t + r) * 512);
}
__device__ __forceinline__ void samp_store(const Params& p, const SampItem& m, const f32x4 (&S)[2], int kq, int l15, int quad) {
    const int kw = m.khalf * 4 + kq;
    float* So = p.out + OUT_SS + (size_t)m.sh * 256 * 512 + (size_t)(32 * kw + quad * 4) * 512 + m.vs16 * 16 + l15;
#pragma unroll
    for (int t = 0; t < 2; ++t)
#pragma unroll
        for (int r = 0; r < 4; ++r) __builtin_nontemporal_store(S[t][r], So + (size_t)(16 * t + r) * 512);
}
__device__ __forceinline__ void gla_samples(const Params& p, LAS unsigned char* lds, int i2_first, int stride, int n, int& step) {
    const int tid = fresh_tid(), lane = tid & 63, w = __builtin_amdgcn_readfirstlane(tid >> 6), l15 = lane & 15, quad = lane >> 4;
    LAS float* red = (LAS float*)lds;
    if (w >= 4) { for (int j = 0; j < n; ++j) { const SampItem m = samp_decode(i2_first + j * stride); gla_consume(p, red, tid - 256, m.slot, m.h, m.khalf, m.vs16, step); } return; }
    const int kq = w;
    SampItem ma = samp_decode(i2_first), mb = ma; ScanOps A, B; f32x4 SA[2], SB[2];
    samp_load(p, ma, A, SA, kq, l15, quad);
    int j = 0;
    for (; j + 1 < n; j += 2) {
        mb = samp_decode(i2_first + (j + 1) * stride); samp_load(p, mb, B, SB, kq, l15, quad);
        gla_step(red, A, SA, kq, lane, step); samp_store(p, ma, SA, kq, l15, quad);
        ma = samp_decode(i2_first + (j + 2 < n ? j + 2 : n - 1) * stride); samp_load(p, ma, A, SA, kq, l15, quad);
        gla_step(red, B, SB, kq, lane, step); samp_store(p, mb, SB, kq, l15, quad);
    }
    if (j < n) { gla_step(red, A, SA, kq, lane, step); samp_store(p, ma, SA, kq, l15, quad); }
}

__device__ __forceinline__ void unpack8(const u32x4 w, float (&f)[8]) { f[0] = bflo(w.x); f[1] = bfhi(w.x); f[2] = bflo(w.y); f[3] = bfhi(w.y); f[4] = bflo(w.z); f[5] = bfhi(w.z); f[6] = bflo(w.w); f[7] = bfhi(w.w); }
__device__ __forceinline__ float sigmoidf_(float x) { return __builtin_amdgcn_rcpf(1.f + __expf(-x)); }
__device__ __forceinline__ void conv_prev(const Params& p, int t, int k, int col, float (&out)[8]) {
    const bf16_t* Ur = (const bf16_t*)(p.ws + WS_UREST);
    const bool samp = t >= ROW_SAMPLE && t < ROW_END; const int si = (t - ROW_SAMPLE) & 15, stream = (t - ROW_SAMPLE) >> 4;
    if (samp && si < k) { const float* c = p.in[3] + ((size_t)stream * 2 + (si - k + 2)) * D + col;
        const f32x4 a = *(const f32x4*)c, b = *(const f32x4*)(c + 4);
#pragma unroll
        for (int j = 0; j < 4; ++j) { out[j] = a[j]; out[4 + j] = b[j]; }
    } else if (t - k >= 0) { unpack8(*(const u32x4*)(Ur + (size_t)(t - k) * 6144 + 2048 + col), out);
    } else {
#pragma unroll
        for (int j = 0; j < 8; ++j) out[j] = 0.f;
    }
}
struct MixIn { u32x4 o, o1, g1, g2, pc; };
__device__ __forceinline__ void mix_load(const Params& p, MixIn& m, int row, int col) {
    const bf16_t* ur = (const bf16_t*)(p.ws + WS_UREST) + (size_t)row * 6144 + col;
    m.o = __builtin_nontemporal_load((const u32x4*)((const bf16_t*)(p.ws + WS_O) + (size_t)row * D + col)); m.o1 = __builtin_nontemporal_load((const u32x4*)((const bf16_t*)(p.ws + WS_O) + (size_t)MP * D + (size_t)row * D + col));
    m.g1 = __builtin_nontemporal_load((const u32x4*)(ur)); m.pc = __builtin_nontemporal_load((const u32x4*)(ur + 2048)); m.g2 = __builtin_nontemporal_load((const u32x4*)(ur + 4096));
}
__device__ __forceinline__ void phase_mix(const Params& p) {
    const int tid_ = fresh_tid(); const int lane = tid_ & 63, w = tid_ >> 6, g = w & 3, half = w >> 2;
    const int col = g * 512 + lane * 8;
    bf16_t* Mb = (bf16_t*)(p.ws + WS_M);
    float gn[8], w0[8], w1[8], w2[8];
    { const float* gp = p.in[10] + col; const float* cp = p.in[11] + col;
#pragma unroll
      for (int j = 0; j < 8; ++j) { gn[j] = gp[j]; w0[j] = cp[j]; w1[j] = cp[D + j]; w2[j] = cp[2 * D + j]; } }
    const int rbeg = blockIdx.x * 34 + half * 17, rend = rbeg + 17;
    float p1[8], p2[8];
    conv_prev(p, rbeg, 1, col, p1); conv_prev(p, rbeg, 2, col, p2);
    MixIn cur; mix_load(p, cur, rbeg, col);
#pragma unroll 1
    for (int row = rbeg; row < rend; ++row) {
        MixIn nx; mix_load(p, nx, row + 1 < rend ? row + 1 : row, col);
        const bool samp = row >= ROW_SAMPLE && row < ROW_END; const int si = (row - ROW_SAMPLE) & 15, stream = (row - ROW_SAMPLE) >> 4;
        if (samp && si == 0) { conv_prev(p, row, 1, col, p1); conv_prev(p, row, 2, col, p2); }
        float o[8], g1[8], g2[8];
        { float ob[8]; unpack8(cur.o, o); unpack8(cur.o1, ob);
#pragma unroll
          for (int j = 0; j < 8; ++j) o[j] += ob[j]; }
        unpack8(cur.g1, g1); unpack8(cur.g2, g2);
        float ss = 0.f;
#pragma unroll
        for (int j = 0; j < 8; ++j) ss += o[j] * o[j];
        const float rs = 1.f / sqrtf(wave_sum(ss) * (1.f / 512.f) + RMS_EPS);
        const bool valid = row >= ROW_META && row < ROW_END;
        float mm[8], p0[8]; unpack8(cur.pc, p0);
#pragma unroll
        for (int j = 0; j < 8; ++j) {
            const float ya = o[j] * rs * gn[j] * g1[j];
            const float cv = w0[j] * p2[j] + w1[j] * p1[j] + w2[j] * p0[j];
            mm[j] = valid ? ya + g2[j] * cv : 0.f;
        }
        *(u32x4*)(Mb + (size_t)row * D + col) = (u32x4){pk2(mm[0], mm[1]), pk2(mm[2], mm[3]), pk2(mm[4], mm[5]), pk2(mm[6], mm[7])};
        float* co = nullptr;
        if (row == ROW_SAMPLE - 2) co = p.out + OUT_CP; else if (row == ROW_SAMPLE - 1) co = p.out + OUT_CP + D;
        else if (samp && si == 14) co = p.out + OUT_CS + ((size_t)stream * 2 + 0) * D; else if (samp && si == 15) co = p.out + OUT_CS + ((size_t)stream * 2 + 1) * D;
        if (co) { *(f32x4*)(co + col) = (f32x4){p0[0], p0[1], p0[2], p0[3]}; *(f32x4*)(co + col + 4) = (f32x4){p0[4], p0[5], p0[6], p0[7]}; }
#pragma unroll
        for (int j = 0; j < 8; ++j) { p2[j] = p1[j]; p1[j] = p0[j]; }
        cur = nx;
    }
}

__device__ __forceinline__ void phase_ln1(const Params& p) {
    const int tid_ = fresh_tid(); const int lane = tid_ & 63, w = tid_ >> 6; const int gw = blockIdx.x * 8 + w, NGW = gridDim.x * 8;
    const bf16_t* T = (const bf16_t*)(p.ws + WS_T1); bf16_t* H = (bf16_t*)(p.ws + WS_H);
    const bf16_t* Part = (const bf16_t*)(p.ws + WS_PART); const bf16_t* XN = (const bf16_t*)(p.ws + WS_XN);
    for (int row = gw; row < MP; row += NGW) { f32x4 v[8];
        if (row < 8192) ln_row(T + (size_t)row * D, p.in[13], p.in[14], lane, v); else ln_row_tail(Part, 8, row, XN, p.in[13], p.in[14], lane, v);
        store_row_bf16(H + (size_t)row * D, lane, v); }
}
__device__ __forceinline__ void phase_ln2(const Params& p) {
    const int tid_ = fresh_tid(); const int lane = tid_ & 63, w = tid_ >> 6; const int gw = blockIdx.x * 8 + w, NGW = gridDim.x * 8;
    const bf16_t* T = (const bf16_t*)(p.ws + WS_T2);
    const bf16_t* Part = (const bf16_t*)(p.ws + WS_PART); const bf16_t* H = (const bf16_t*)(p.ws + WS_H);
    for (int row = ROW_PROMPT + gw; row < ROW_END; row += NGW) { f32x4 v[8];
        if (row < 8192) ln_row(T + (size_t)row * D, p.in[17], p.in[18], lane, v); else ln_row_tail(Part, 11, row, H, p.in[17], p.in[18], lane, v);
        float* orow = row < ROW_SAMPLE ? p.out + OUT_YP + (size_t)(row - ROW_PROMPT) * D : p.out + OUT_YS + (size_t)(row - ROW_SAMPLE) * D;
#pragma unroll
        for (int j = 0; j < 8; ++j) __builtin_nontemporal_store(v[j], (f32x4*)(orow + 4 * lane + 256 * j)); }
}


#define XB_TMO      128
#define XB_XCNT(j)  (256  + 64 * (j))
#define XB_XSUB(j)  (1280 + 64 * (j))
#define XB_XGEN(j)  (2304 + 64 * (j))
#define XB_TOP      3328
#define XB_TOPGEN   3392
#define XCD_BAR_WORDS 3456
#define XB_SPIN_CAP (1u << 18)
__device__ __forceinline__ unsigned xb_ld(unsigned* p)              { return __hip_atomic_load(p, __ATOMIC_RELAXED, __HIP_MEMORY_SCOPE_AGENT); }
__device__ __forceinline__ unsigned xb_add(unsigned* p, unsigned v) { return __hip_atomic_fetch_add(p, v, __ATOMIC_RELAXED, __HIP_MEMORY_SCOPE_AGENT); }
__device__ __forceinline__ unsigned xb_xcc_id() { return (unsigned)__builtin_amdgcn_s_getreg((3 << 11) | 20) & 0xFu; }
#define XB_SPIN(cond, bar) do { unsigned _sp = 0; while (cond) { __builtin_amdgcn_s_sleep(1); \
    if ((++_sp & 255u) == 0u) { if (xb_ld(&(bar)[XB_TMO])) break; if (_sp > XB_SPIN_CAP) { atomicAdd(&(bar)[XB_TMO], 1u); break; } } } } while (0)
struct XcdBarrier { unsigned* bar; unsigned x; volatile LAS unsigned* st; };
__device__ __forceinline__ XcdBarrier xcd_barrier_post(unsigned* bar, volatile LAS unsigned* st) {
    XcdBarrier b; b.bar = bar; b.x = xb_xcc_id(); b.st = st;
    if (threadIdx.x == 0) (void)xb_add(&bar[XB_XCNT(b.x)], 1u);
    return b;
}
__device__ __forceinline__ void xcd_barrier_complete(unsigned* bar, unsigned x, unsigned& nloc, unsigned& nx) {
    const unsigned G = gridDim.x * gridDim.y * gridDim.z;
    unsigned sum, cnt, mine, sp = 0u;
    for (;;) {
        sum = 0u; cnt = 0u; mine = 0u;
#pragma unroll
        for (unsigned j = 0; j < 16; ++j) { const unsigned c = xb_ld(&bar[XB_XCNT(j)]); sum += c; cnt += (c > 0u) ? 1u : 0u; mine = (j == x) ? c : mine; }
        if (sum == G) break;
        __builtin_amdgcn_s_sleep(1);
        if ((++sp & 255u) == 0u) { if (xb_ld(&bar[XB_TMO])) break; if (sp > XB_SPIN_CAP) { atomicAdd(&bar[XB_TMO], 1u); break; } }
    }
    nloc = mine > 0u ? mine : 1u; nx = cnt > 0u ? cnt : 1u;
}
__device__ __forceinline__ void xcd_barrier(const XcdBarrier& b) {
    asm volatile("s_waitcnt vmcnt(0)" ::: "memory");
    __syncthreads();
    if (threadIdx.x == 0) {
        unsigned* bar = b.bar;
        __builtin_amdgcn_s_waitcnt(0);
        unsigned nloc = b.st[0], nx = b.st[1];
        if (nloc == 0u) { xcd_barrier_complete(bar, b.x, nloc, nx); b.st[0] = nloc; b.st[1] = nx; }
        const unsigned old = xb_add(&bar[XB_XSUB(b.x)], 1u);
        const unsigned gen = old / nloc;
        if (old + 1u == (gen + 1u) * nloc) {
            __builtin_amdgcn_fence(__ATOMIC_RELEASE, "agent");
            asm volatile("s_waitcnt vmcnt(0)" ::: "memory");
            const unsigned og = xb_add(&bar[XB_TOP], 1u);
            const unsigned tg = og / nx;
            if (og + 1u == (tg + 1u) * nx) xb_add(&bar[XB_TOPGEN], 1u);
            else XB_SPIN(xb_ld(&bar[XB_TOPGEN]) == tg, bar);
            __builtin_amdgcn_fence(__ATOMIC_ACQUIRE, "agent");
            xb_add(&bar[XB_XGEN(b.x)], 1u);
            asm volatile("s_waitcnt vmcnt(0)" ::: "memory");
        } else {
            XB_SPIN(xb_ld(&bar[XB_XGEN(b.x)]) == gen, bar);
            __builtin_amdgcn_fence(__ATOMIC_ACQUIRE, "agent");
            asm volatile("s_waitcnt vmcnt(0)" ::: "memory");
        }
    }
    __syncthreads();
}

#ifndef DUP
#define DUP 0
#ifndef DUPC
#define DUPC 0
#endif
#ifndef DUPS
#define DUPS 0
#endif
#endif
#define REP(bit) for (int _rep = 0; _rep < (((DUP) >> (bit)) & 1) + 1; ++_rep)
__global__ void __launch_bounds__(512, 2) fwd_megakernel(Params p) {
    extern __shared__ __attribute__((aligned(16))) unsigned char shm_raw[];
    LAS unsigned char* lds = (LAS unsigned char*)shm_raw;
    cg::grid_group grid = cg::this_grid();
    const int G = gridDim.x, bid = blockIdx.x;
    if (p.ws == nullptr) grid.sync();
    volatile LAS unsigned* xst = (volatile LAS unsigned*)(lds + pg8::STAGE_BYTES);
    if (threadIdx.x == 0) { xst[0] = 0u; xst[1] = 0u; }
    __syncthreads();
    const XcdBarrier xb = xcd_barrier_post((unsigned*)(p.ws + WS_BAR), xst);

    REP(0) { phase0(p, lds);
    xcd_barrier(xb); }
    REP(1) { pg8::Gemm g{(const bf16_t*)(p.ws + WS_XN), (const bf16_t*)(p.ws + WS_BT1), MP, N1, D};
      pg8::StaticOrder S; S.init(MP, N1, D, G, bid);
      EpiU E{(bf16_t*)(p.ws + WS_UQKV), (bf16_t*)(p.ws + WS_UREST), (float*)(p.ws + WS_A)};
      pg8::gemm_phase<EpiU, pg8::StaticOrder, true, true>(lds, g, S, E);
      if (bid >= 162) { const int tid_ = fresh_tid(); transposes<4>(p, lds, TR_ALL - TR_IDLE, TR_ALL, (bid - 162) * 8 + (tid_ >> 6), 94 * 8, tid_ >> 6, tid_ & 63); }
    xcd_barrier(xb); }
    REP(2) { for (int it = bid; it < NITEM; it += G) gla_prep_item(p, lds, it);
    xcd_barrier(xb); }
    REP(3) { int step = 0;
      gla_chain(p, lds, 0, 129, (bid & 7) >> 1, bid & 1, bid >> 3, p.out + OUT_SP + (size_t)((bid & 7) >> 1) * 256 * 512, step);
      __syncthreads();
      gla_samples(p, lds, ((bid & 7) >> 1) * 64 + (bid & 1) * 32 + (bid >> 3), 256, 16, step);
      if (G >= 256 && bid >= 128) {
          __syncthreads();
          const int tid_ = fresh_tid();
          transposes<4>(p, lds, TR_SPLIT, TR_ALL, (bid - 128) * 8 + (tid_ >> 6), (G - 128) * 8, tid_ >> 6, tid_ & 63);
      }
    xcd_barrier(xb); }
    REP(4) { phase_mix(p);
    xcd_barrier(xb); }
    REP(5) { pg8::Gemm g{(const bf16_t*)(p.ws + WS_M), (const bf16_t*)(p.ws + WS_BT2), MP, D, D};
      pg8::TailOrder S; S.init(D, bid, 8, 4);
      EpiRes E{(bf16_t*)(p.ws + WS_T1), (const bf16_t*)(p.ws + WS_XN), (bf16_t*)(p.ws + WS_PART)};
      pg8::gemm_phase<EpiRes, pg8::TailOrder, true, true>(lds, g, S, E);
    xcd_barrier(xb); }
    REP(6) { phase_ln1(p);
    xcd_barrier(xb); }
    REP(7) { pg8::Gemm g{(const bf16_t*)(p.ws + WS_H), (const bf16_t*)(p.ws + WS_BT3), MP, N3, D};
      pg8::StaticOrder S; S.init(MP, N3, D, G, bid);
      EpiSwiglu E{(bf16_t*)(p.ws + WS_ACT)};
      pg8::gemm_phase<EpiSwiglu, pg8::StaticOrder, true, true>(lds, g, S, E);
    xcd_barrier(xb); }
    REP(8) { pg8::Gemm g{(const bf16_t*)(p.ws + WS_ACT), (const bf16_t*)(p.ws + WS_BT4), MP, D, DFF};
      pg8::TailOrder S; S.init(DFF, bid, 11, 8);
      EpiRes E{(bf16_t*)(p.ws + WS_T2), (const bf16_t*)(p.ws + WS_H), (bf16_t*)(p.ws + WS_PART)};
      pg8::gemm_phase<EpiRes, pg8::TailOrder, true, true>(lds, g, S, E);
    xcd_barrier(xb); }
    REP(9) phase_ln2(p);
}

extern "C" void kernel_launch(void* const* d_in, const int* in_sizes, int n_in, void* d_out, int out_size, void* d_ws, size_t ws_size, hipStream_t stream) {
    constexpr size_t kDynLds = pg8::STAGE_BYTES + 16;
    static int grid_blocks = 0;
    if (!grid_blocks) {
        if (n_in != 19 || ws_size < WS_END) { fprintf(stderr, "kernel_launch: unexpected n_in %d / ws_size %zu (need %zu)\n", n_in, ws_size, (size_t)WS_END); grid_blocks = -1; return; }
        int dev = 0, cus = 0, per_cu = 0;
        hipGetDevice(&dev);
        hipDeviceGetAttribute(&cus, hipDeviceAttributeMultiprocessorCount, dev);
        hipFuncSetAttribute((const void*)fwd_megakernel, hipFuncAttributeMaxDynamicSharedMemorySize, (int)kDynLds);
        hipOccupancyMaxActiveBlocksPerMultiprocessor(&per_cu, (const void*)fwd_megakernel, 512, kDynLds);
        if (per_cu < 1) { fprintf(stderr, "kernel_launch: occupancy query says %d blocks/CU\n", per_cu); grid_blocks = -1; return; }
        if (cus != 256) { fprintf(stderr, "kernel_launch: built for 256 CUs, device has %d\n", cus); grid_blocks = -1; return; }
        grid_blocks = cus;
    }
    if (grid_blocks < 0) return;
    if (hipMemsetAsync((char*)d_ws + WS_BAR, 0, 16384, stream) != hipSuccess) { fprintf(stderr, "kernel_launch: memset of the barrier words failed\n"); return; }
    Params p{};
    for (int i = 0; i < 19; ++i) p.in[i] = (const float*)d_in[i];
    p.out = (float*)d_out; p.ws = (unsigned char*)d_ws;
    void* args[] = {&p};
    hipError_t e = hipLaunchCooperativeKernel((const void*)fwd_megakernel, dim3(grid_blocks), dim3(512), args, kDynLds, stream);
    if (e != hipSuccess) fprintf(stderr, "cooperative launch failed: %s (grid %d)\n", hipGetErrorString(e), grid_blocks);
}
```

```cpp
#include <hip/hip_runtime.h>
#include <hip/hip_cooperative_groups.h>
#include <cstdio>
#include <cstdint>
namespace cg = cooperative_groups;

#define LAS __attribute__((address_space(3)))
typedef unsigned short bf16_t;
typedef short bf16x8 __attribute__((ext_vector_type(8)));
typedef float f32x4 __attribute__((ext_vector_type(4)));
typedef float f32x2 __attribute__((ext_vector_type(2)));
typedef unsigned u32x4 __attribute__((ext_vector_type(4)));
typedef unsigned u32x2 __attribute__((ext_vector_type(2)));
typedef __bf16 bf16x2n __attribute__((ext_vector_type(2)));

__device__ __forceinline__ unsigned pk2(float lo, float hi) { f32x2 v = {lo, hi}; bf16x2n r = __builtin_convertvector(v, bf16x2n); return __builtin_bit_cast(unsigned, r); }
__device__ __forceinline__ float bf2f(unsigned b) { return __uint_as_float(b << 16); }
__device__ __forceinline__ float bflo(unsigned w) { return __uint_as_float(w << 16); }
__device__ __forceinline__ float bfhi(unsigned w) { return __uint_as_float(w & 0xffff0000u); }
__device__ __forceinline__ float wave_sum(float v) {
#pragma unroll
    for (int o = 1; o < 64; o <<= 1) v += __shfl_xor(v, o);
    return v;
}
#define LDS_WAIT() asm volatile("s_waitcnt lgkmcnt(0)" ::: "memory")
__device__ __forceinline__ int fresh_tid() { int t = threadIdx.x; asm volatile("" : "+v"(t)); return t; }

constexpr int D = 2048, MP = 8704, DFF = 5632;
constexpr int N1 = 16640, N3 = 2 * DFF;
constexpr int ROW_META = 48, ROW_PROMPT = 64, ROW_SAMPLE = 8256, ROW_END = 8512;
constexpr int NSLOT = 145, NITEM = NSLOT * 4;
constexpr float ALPHA = 1.189207115002721f;
constexpr float LN_EPS = 1e-5f, RMS_EPS = 1e-6f;
constexpr size_t WS_BT1 = 0;
constexpr size_t WS_BT2 = WS_BT1 + (size_t)N1 * D * 2;
constexpr size_t WS_BT3 = WS_BT2 + (size_t)D * D * 2;
constexpr size_t WS_BT4 = WS_BT3 + (size_t)N3 * D * 2;
constexpr size_t WS_XN = WS_BT4 + (size_t)D * DFF * 2;
constexpr size_t WS_UQKV = WS_XN + (size_t)MP * D * 2;
constexpr size_t WS_UREST = WS_UQKV + (size_t)MP * 4096 * 2;
constexpr size_t WS_A = WS_UREST + (size_t)MP * 12288 * 2;
constexpr size_t WS_VT = WS_A + (size_t)MP * 16 * 4;
constexpr size_t WS_BAR = WS_VT + (size_t)NITEM * 512 * 64 * 2;
constexpr size_t WS_ZERO = WS_BAR + 15360;
constexpr size_t WS_END = WS_BAR + 16384;
constexpr size_t WS_QT = WS_BT1;
constexpr size_t WS_KD = WS_QT + (size_t)NITEM * 64 * 256 * 2;
constexpr size_t WS_PM = WS_KD + (size_t)NITEM * 256 * 64 * 2;
constexpr size_t WS_DL = WS_PM + (size_t)NITEM * 64 * 64 * 2;
constexpr size_t WS_O = WS_UQKV;
constexpr size_t WS_M = WS_VT;
constexpr size_t WS_T1 = WS_UQKV;
constexpr size_t WS_H = WS_UREST;
constexpr size_t WS_ACT = WS_UREST + (size_t)MP * D * 2;
constexpr size_t WS_T2 = WS_UQKV;
constexpr size_t WS_PART = WS_BT1;
static_assert((size_t)16 * 512 * D * 4 <= (size_t)N1 * D * 2, "partials must fit in Bt1");
static_assert(WS_DL + (size_t)NITEM * 256 * 4 <= WS_BT2, "prep buffers must fit in Bt1");
static_assert((size_t)MP * D * 2 <= (size_t)NITEM * 512 * 64 * 2, "m must fit in VT");
constexpr size_t OUT_YP = 0;
constexpr size_t OUT_YS = OUT_YP + (size_t)8192 * D;
constexpr size_t OUT_SP = OUT_YS + (size_t)256 * D;
constexpr size_t OUT_CP = OUT_SP + (size_t)4 * 256 * 512;
constexpr size_t OUT_SS = OUT_CP + (size_t)2 * D;
constexpr size_t OUT_CS = OUT_SS + (size_t)16 * 4 * 256 * 512;

struct Params { const float* in[19]; float* out; unsigned char* ws; };

namespace pg8 {
#define PG8_LAS __attribute__((address_space(3)))
constexpr int BM = 256, BK = 64, HALF = 128, HTB = HALF * BK * 2, STAGE_BYTES = 8 * HTB, NXCD = 8, WGM = 4;
__host__ __device__ __forceinline__ int lds_byte(int r, int c) { const int st = (r >> 4) * 2 + (c >> 5), rr = r & 15, cc = c & 31, ob = rr * 64 + cc * 2; return st * 1024 + (ob ^ (((ob >> 9) & 1) << 5)); }
__host__ __device__ __forceinline__ void stage_rc(int b, int& R, int& C) { const int st = b / 1024, sb = b % 1024, swz = sb ^ (((sb >> 9) & 1) << 5); R = (st >> 1) * 16 + swz / 64; C = (st & 1) * 32 + (swz % 64) / 2; }
__host__ __device__ __forceinline__ int perm32(int rho) { const int n = rho >> 4, i = rho & 15; return 8 * (i >> 2) + 4 * n + (i & 3); }
struct Unit { int pm, pn, kt0, nt, part; };
struct Gemm { const bf16_t* A; const bf16_t* Bt; int M, N, K; };
struct StaticOrder {
    int nM, nN, nwg, G, c, knt;
    __host__ __device__ void init(int M, int N, int K, int G_, int c_) { nM = M / BM; nN = N / BM; nwg = nM * nN; G = G_; c = c_; knt = K / BK; }
    __host__ __device__ bool next(int i, Unit& u) const {
        const long L = (long)i * G + c; if (L >= nwg) return false;
        int wgid = (int)L; { const int q = nwg / NXCD, r = nwg % NXCD, xcd = wgid % NXCD, off = wgid / NXCD; wgid = (xcd < r ? xcd * (q + 1) : r * (q + 1) + (xcd - r) * q) + off; }
        const int nig = WGM * nN, gid = wgid / nig, fm = gid * WGM, gsz = (nM - fm) < WGM ? (nM - fm) : WGM;
        u.pm = fm + ((wgid % nig) % gsz); u.pn = (wgid % nig) / gsz; u.kt0 = 0; u.nt = knt; u.part = -1; return true;
    }
    __device__ __forceinline__ void a_ready(const Unit&) const {}
    __device__ __forceinline__ void done(const Unit&) const {}
};

struct TailOrder {
    int c, knt, P, ntp;
    __host__ __device__ void init(int K, int c_, int P_, int ntp_) { c = c_; knt = K / BK; P = P_; ntp = ntp_; }
    __host__ __device__ bool next(int i, Unit& u) const {
        if (i == 0) { u.pm = (c & 7) * 4 + ((c >> 3) & 3); u.pn = c >> 5; u.kt0 = 0; u.nt = knt; u.part = -1; return true; }
        if (i == 1 && c < 16 * P) { const int lu = c / P, part = c - lu * P; u.pm = 32 + (lu >> 3); u.pn = lu & 7; u.kt0 = part * ntp; u.nt = (knt - u.kt0) < ntp ? (knt - u.kt0) : ntp; u.part = part; return true; }
        return false;
    }
    __device__ __forceinline__ void a_ready(const Unit&) const {}
    __device__ __forceinline__ void done(const Unit&) const {}
};

template <class Epi, class Sched, bool ALIGN_EPI = false, bool SP2 = false>
__device__ __forceinline__ void gemm_phase(PG8_LAS unsigned char* lds, const Gemm g, const Sched& S, const Epi& E) {
    const int tid = threadIdx.x, wid = __builtin_amdgcn_readfirstlane(tid >> 6), lane = tid & 63, wr = wid >> 2, wc = wid & 3, fr = lane & 15, fq = lane >> 4;
    const int K = g.K;
    unsigned voffA[2], voffB[2];
#pragma unroll
    for (int i = 0; i < 2; ++i) { int R, C; stage_rc(tid * 16 + i * 8192, R, C); const int Rb = Epi::PERM ? ((R & ~31) + perm32(R & 31)) : R;
        voffA[i] = (unsigned)(R * K + C) * 2u; voffB[i] = (unsigned)(Rb * K + C) * 2u; }
    const size_t kstep = (size_t)(BK * 2);
    const size_t hstep = (size_t)HALF * K * 2;
    const size_t tstep = 2 * hstep;
    const unsigned ldsw = (unsigned)wid * 1024u;
    const int aoff = lds_byte(wr * 64 + fr, fq * 8), boff = lds_byte(wc * 32 + fr, fq * 8);
#define PG8_SA(b, h) (((b) * 2 + (h)) * HTB)
#define PG8_SB(b, h) ((4 + (b) * 2 + (h)) * HTB)
#define PG8_STAGE(bufoff, gbase, voff) do { _Pragma("unroll") for (int _i = 0; _i < 2; ++_i) \
        __builtin_amdgcn_global_load_lds((const unsigned*)((const char*)(gbase) + (voff)[_i]), (PG8_LAS unsigned*)(lds + (bufoff) + ldsw + _i * 8192), 16, 0, 0); } while (0)
#define PG8_LDA(dst, b, h) do { _Pragma("unroll") for (int m = 0; m < 4; ++m) _Pragma("unroll") for (int k = 0; k < 2; ++k) dst[m][k] = *(const PG8_LAS bf16x8*)(lds + PG8_SA(b, h) + aoff + m * 2048 + k * 1024); } while (0)
#define PG8_LDB(dst, b, h) do { _Pragma("unroll") for (int n = 0; n < 2; ++n) _Pragma("unroll") for (int k = 0; k < 2; ++k) dst[n][k] = *(const PG8_LAS bf16x8*)(lds + PG8_SB(b, h) + boff + n * 2048 + k * 1024); } while (0)
#define PG8_MMA(ai, bj, At, Bt) do { __builtin_amdgcn_s_setprio(1); _Pragma("unroll") for (int m = 0; m < 4; ++m) _Pragma("unroll") for (int n = 0; n < 2; ++n) _Pragma("unroll") for (int k = 0; k < 2; ++k) \
        acc[ai][bj][m][n] = __builtin_amdgcn_mfma_f32_16x16x32_bf16(Bt[n][k], At[m][k], acc[ai][bj][m][n], 0, 0, 0); __builtin_amdgcn_s_setprio(0); } while (0)
#define PG8_WAIT_V(n) asm volatile("s_waitcnt vmcnt(" #n ")" ::: "memory")
#define PG8_WAIT_L(n) asm volatile("s_waitcnt lgkmcnt(" #n ")" ::: "memory")
#define PG8_BAR __builtin_amdgcn_s_barrier()
#define PG8_SCHED __builtin_amdgcn_sched_barrier(0)
    Unit cur, nxt; int ui = 0;
    if (!S.next(0, cur)) return;
    f32x4 acc[2][2][4][2];
#pragma unroll
    for (int a = 0; a < 2; ++a)
#pragma unroll
        for (int b = 0; b < 2; ++b)
#pragma unroll
            for (int m = 0; m < 4; ++m)
#pragma unroll
                for (int n = 0; n < 2; ++n) acc[a][b][m][n] = (f32x4){0.f, 0.f, 0.f, 0.f};
    bf16x8 At[4][2], B0[2][2], B1[2][2];
    const char* cA = (const char*)g.A + (size_t)cur.pm * tstep + (size_t)cur.kt0 * kstep; const char* cB = (const char*)g.Bt + (size_t)cur.pn * tstep + (size_t)cur.kt0 * kstep;
    S.a_ready(cur);
    if constexpr (SP2) {
        PG8_STAGE(PG8_SB(0, 0), cB, voffB); PG8_STAGE(PG8_SB(0, 1), cB + hstep, voffB); PG8_STAGE(PG8_SA(0, 0), cA, voffA); PG8_STAGE(PG8_SA(0, 1), cA + hstep, voffA);
        if (wr == 1) PG8_BAR;
        PG8_WAIT_V(2); PG8_BAR;
        PG8_STAGE(PG8_SB(1, 0), cB + kstep, voffB); PG8_STAGE(PG8_SA(1, 0), cA + kstep, voffA); PG8_STAGE(PG8_SB(1, 1), cB + hstep + kstep, voffB);
        PG8_WAIT_V(6); PG8_BAR;
    } else {
        PG8_STAGE(PG8_SB(0, 0), cB, voffB); PG8_STAGE(PG8_SA(0, 0), cA, voffA); PG8_STAGE(PG8_SB(0, 1), cB + hstep, voffB); PG8_STAGE(PG8_SA(0, 1), cA + hstep, voffA);
        if (wr == 1) PG8_BAR;
        PG8_WAIT_V(4); PG8_BAR;
        PG8_STAGE(PG8_SB(1, 0), cB + kstep, voffB); PG8_STAGE(PG8_SA(1, 0), cA + kstep, voffA); PG8_STAGE(PG8_SB(1, 1), cB + hstep + kstep, voffB);
        PG8_WAIT_V(6); PG8_BAR;
    }
    for (;;) {
        const bool has_next = S.next(ui + 1, nxt);
        const char* nA = has_next ? (const char*)g.A + (size_t)nxt.pm * tstep + (size_t)nxt.kt0 * kstep : cA; const char* nB = has_next ? (const char*)g.Bt + (size_t)nxt.pn * tstep + (size_t)nxt.kt0 * kstep : cB;
        const int nt = cur.nt;
        for (int t = 0; t < nt; t += 2) {
            const bool last = (t == nt - 2);
            const char* a1 = cA + (size_t)(t + 1) * kstep;
            const char* a2 = last ? nA : cA + (size_t)(t + 2) * kstep; const char* b2 = last ? nB : cB + (size_t)(t + 2) * kstep;
            const char* a3 = a2 + kstep; const char* b3 = b2 + kstep;
            if (last && has_next) S.a_ready(nxt);
            if constexpr (SP2) {
            PG8_LDB(B0, 0, 0); PG8_LDB(B1, 0, 1); PG8_SCHED; PG8_LDA(At, 0, 0); PG8_STAGE(PG8_SA(1, 1), a1 + hstep, voffA);
            PG8_WAIT_V(8); PG8_WAIT_L(0); PG8_BAR; PG8_MMA(0, 0, At, B0); PG8_MMA(0, 1, At, B1); PG8_BAR; PG8_SCHED;
            PG8_LDA(At, 0, 1); PG8_STAGE(PG8_SB(0, 0), b2, voffB); PG8_STAGE(PG8_SB(0, 1), b2 + hstep, voffB); PG8_STAGE(PG8_SA(0, 0), a2, voffA);
            PG8_WAIT_V(8); PG8_WAIT_L(0); PG8_BAR; PG8_MMA(1, 0, At, B0); PG8_MMA(1, 1, At, B1); PG8_BAR; PG8_SCHED;
            PG8_LDB(B0, 1, 0); PG8_LDB(B1, 1, 1); PG8_SCHED; PG8_LDA(At, 1, 0); PG8_STAGE(PG8_SA(0, 1), a2 + hstep, voffA);
            PG8_WAIT_V(8); PG8_WAIT_L(0); PG8_BAR; PG8_MMA(0, 0, At, B0); PG8_MMA(0, 1, At, B1); PG8_BAR; PG8_SCHED;
            PG8_LDA(At, 1, 1); PG8_STAGE(PG8_SB(1, 0), b3, voffB); PG8_STAGE(PG8_SB(1, 1), b3 + hstep, voffB); PG8_STAGE(PG8_SA(1, 0), a3, voffA);
            PG8_WAIT_V(8); PG8_WAIT_L(0); PG8_BAR; PG8_MMA(1, 0, At, B0); PG8_MMA(1, 1, At, B1); PG8_BAR; PG8_SCHED;
            } else {
            PG8_LDB(B0, 0, 0); PG8_SCHED; PG8_LDA(At, 0, 0); PG8_STAGE(PG8_SA(1, 1), a1 + hstep, voffA);
            PG8_WAIT_L(8); PG8_BAR; PG8_WAIT_L(0); PG8_MMA(0, 0, At, B0); PG8_BAR; PG8_SCHED;
            PG8_LDB(B1, 0, 1); PG8_STAGE(PG8_SB(0, 0), b2, voffB);
            PG8_BAR; PG8_WAIT_L(0); PG8_MMA(0, 1, At, B1); PG8_BAR;
            PG8_LDA(At, 0, 1); PG8_STAGE(PG8_SA(0, 0), a2, voffA);
            PG8_BAR; PG8_WAIT_L(0); PG8_MMA(1, 0, At, B0); PG8_BAR; PG8_SCHED;
            PG8_STAGE(PG8_SB(0, 1), b2 + hstep, voffB);
            PG8_WAIT_V(6); PG8_BAR; PG8_MMA(1, 1, At, B1); PG8_BAR;
            PG8_LDB(B0, 1, 0); PG8_SCHED; PG8_LDA(At, 1, 0); PG8_STAGE(PG8_SA(0, 1), a2 + hstep, voffA);
            PG8_WAIT_L(8); PG8_BAR; PG8_WAIT_L(0); PG8_MMA(0, 0, At, B0); PG8_BAR; PG8_SCHED;
            PG8_LDB(B1, 1, 1); PG8_STAGE(PG8_SB(1, 0), b3, voffB);
            PG8_BAR; PG8_WAIT_L(0); PG8_MMA(0, 1, At, B1); PG8_BAR;
            PG8_LDA(At, 1, 1); PG8_STAGE(PG8_SA(1, 0), a3, voffA);
            PG8_BAR; PG8_WAIT_L(0); PG8_MMA(1, 0, At, B0); PG8_BAR; PG8_SCHED;
            PG8_STAGE(PG8_SB(1, 1), b3 + hstep, voffB);
            PG8_WAIT_V(6); PG8_BAR; PG8_MMA(1, 1, At, B1); PG8_BAR;
            }
        }
        if constexpr (ALIGN_EPI) { if (wr == 0) PG8_BAR; }
        E(acc, cur, wr, wc, fr, fq);
        if (!has_next) break;
#pragma unroll
        for (int a = 0; a < 2; ++a)
#pragma unroll
            for (int b = 0; b < 2; ++b)
#pragma unroll
                for (int m = 0; m < 4; ++m)
#pragma unroll
                    for (int n = 0; n < 2; ++n) acc[a][b][m][n] = (f32x4){0.f, 0.f, 0.f, 0.f};
        cur = nxt; cA = nA; cB = nB; ++ui;
        if constexpr (ALIGN_EPI) { if (wr == 1) PG8_BAR; }
    }
    PG8_WAIT_V(0);
    if constexpr (!ALIGN_EPI) { if (wr == 0) PG8_BAR; }
    PG8_BAR;
#undef PG8_SA
#undef PG8_SB
#undef PG8_STAGE
#undef PG8_LDA
#undef PG8_LDB
#undef PG8_MMA
#undef PG8_WAIT_V
#undef PG8_WAIT_L
#undef PG8_BAR
#undef PG8_SCHED
}
}

struct EpiU {
    static constexpr bool PERM = true;
    bf16_t* Uqkv; bf16_t* Urest; float* Abuf;
    __device__ __forceinline__ void operator()(const f32x4 (&acc)[2][2][4][2], const pg8::Unit& u, int wr, int wc, int fr, int fq) const {
        const int row0 = u.pm * 256 + wr * 64 + fr;
        if (u.pn == 64) {
            if (wc == 0 && fq < 2) {
#pragma unroll
                for (int ai = 0; ai < 2; ++ai)
#pragma unroll
                    for (int m = 0; m < 4; ++m) { float* rp = Abuf + (size_t)(row0 + ai * 128 + m * 16) * 16 + 8 * fq;
                        *(f32x4*)(rp) = acc[ai][0][m][0]; *(f32x4*)(rp + 4) = acc[ai][0][m][1]; }
            }
        } else if (u.pn >= 16) {
            const int grp = (u.pn - 16) >> 4;
            const int col0 = grp * 2048 + ((u.pn - 16) & 15) * 128 + wc * 32 + 8 * fq;
#pragma unroll
            for (int ai = 0; ai < 2; ++ai)
#pragma unroll
                for (int m = 0; m < 4; ++m) { bf16_t* rp = Urest + (size_t)(row0 + ai * 128 + m * 16) * 6144 + col0;
                    float r[8];
#pragma unroll
                    for (int n = 0; n < 2; ++n)
#pragma unroll
                        for (int j = 0; j < 4; ++j) { const float a0 = acc[ai][0][m][n][j], a1 = acc[ai][1][m][n][j];
                            float v = a0 * a1;
                            if (grp != 1) { v = a0 * __builtin_amdgcn_rcpf(1.f + __expf(-a1)); if (grp == 0) v *= __builtin_amdgcn_rcpf(1.f + __expf(-a0)); }
                            r[n * 4 + j] = v; }
                    u32x4 o; o.x = pk2(r[0], r[1]); o.y = pk2(r[2], r[3]); o.z = pk2(r[4], r[5]); o.w = pk2(r[6], r[7]);
                    __builtin_nontemporal_store(o, (u32x4*)rp); }
        } else {
            const int col0 = u.pn * 256 + wc * 32 + 8 * fq;
#pragma unroll
            for (int ai = 0; ai < 2; ++ai)
#pragma unroll
                for (int m = 0; m < 4; ++m) { bf16_t* rp = Uqkv + (size_t)(row0 + ai * 128 + m * 16) * 4096 + col0;
#pragma unroll
                    for (int bj = 0; bj < 2; ++bj) { const f32x4 v0 = acc[ai][bj][m][0], v1 = acc[ai][bj][m][1];
                        u32x4 o; o.x = pk2(v0[0], v0[1]); o.y = pk2(v0[2], v0[3]); o.z = pk2(v1[0], v1[1]); o.w = pk2(v1[2], v1[3]);
                        *(u32x4*)(rp + bj * 128) = o; } }
        }
    }
};
struct EpiRes {
    static constexpr bool PERM = false;
    bf16_t* C; const bf16_t* R; bf16_t* Part;
    __device__ __forceinline__ void operator()(const f32x4 (&acc)[2][2][4][2], const pg8::Unit& u, int wr, int wc, int fr, int fq) const {
        const int row0 = u.pm * 256 + wr * 64 + fr, col0 = u.pn * 256 + wc * 32 + 4 * fq;
        if (u.part >= 0) {
            bf16_t* P = Part + (size_t)u.part * 512 * D;
#pragma unroll
            for (int ai = 0; ai < 2; ++ai)
#pragma unroll
                for (int m = 0; m < 4; ++m) { const size_t ro = (size_t)(row0 + ai * 128 + m * 16 - 8192) * D + col0;
#pragma unroll
                    for (int bj = 0; bj < 2; ++bj)
#pragma unroll
                        for (int n = 0; n < 2; ++n) { const f32x4 v = acc[ai][bj][m][n]; *(u32x2*)(P + ro + bj * 128 + n * 16) = (u32x2){pk2(v[0], v[1]), pk2(v[2], v[3])}; } }
            return;
        }
#pragma unroll
        for (int ai = 0; ai < 2; ++ai)
#pragma unroll
            for (int m = 0; m < 4; ++m) { const size_t ro = (size_t)(row0 + ai * 128 + m * 16) * D + col0;
#pragma unroll
                for (int bj = 0; bj < 2; ++bj)
#pragma unroll
                    for (int n = 0; n < 2; ++n) { const u32x2 rr = *(const u32x2*)(R + ro + bj * 128 + n * 16);
                        f32x4 v = acc[ai][bj][m][n];
                        v[0] += ALPHA * bflo(rr.x); v[1] += ALPHA * bfhi(rr.x); v[2] += ALPHA * bflo(rr.y); v[3] += ALPHA * bfhi(rr.y);
                        *(u32x2*)(C + ro + bj * 128 + n * 16) = (u32x2){pk2(v[0], v[1]), pk2(v[2], v[3])}; } }
    }
};
struct EpiSwiglu {
    static constexpr bool PERM = true;
    bf16_t* O;
    __device__ __forceinline__ void operator()(const f32x4 (&acc)[2][2][4][2], const pg8::Unit& u, int wr, int wc, int fr, int fq) const {
        const int row0 = u.pm * 256 + wr * 64 + fr, col0 = u.pn * 128 + wc * 32 + 8 * fq;
#pragma unroll
        for (int ai = 0; ai < 2; ++ai)
#pragma unroll
            for (int m = 0; m < 4; ++m) { bf16_t* rp = O + (size_t)(row0 + ai * 128 + m * 16) * DFF + col0;
                float r[8];
#pragma unroll
                for (int n = 0; n < 2; ++n)
#pragma unroll
                    for (int j = 0; j < 4; ++j) { const float gt = acc[ai][0][m][n][j], up = acc[ai][1][m][n][j];
                        r[n * 4 + j] = gt * up * __builtin_amdgcn_rcpf(1.f + __expf(-gt)); }
                u32x4 o; o.x = pk2(r[0], r[1]); o.y = pk2(r[2], r[3]); o.z = pk2(r[4], r[5]); o.w = pk2(r[6], r[7]);
                *(u32x4*)(rp) = o; }
    }
};

template <int NB, bool NTS = false> __device__ __forceinline__ void tr_item(const float* W, int ldw, int k0, int srcc0, int nvalid, bf16_t* WT, int K, int drow0, LAS unsigned* scr, int lane) {
    const int cq = (lane & 15) * 4, kq = lane >> 4;
    const float* src0 = W + (size_t)(k0 + 2 * kq) * ldw + srcc0 + cq;
#pragma unroll
    for (int hh = 0; hh < 8 / NB; ++hh) {
        f32x4 a[NB], b[NB];
#pragma unroll
        for (int ii = 0; ii < NB; ++ii) { a[ii] = (f32x4){0.f, 0.f, 0.f, 0.f}; b[ii] = a[ii];
            if (cq < nvalid) { const float* src = src0 + (size_t)(8 * (NB * hh + ii)) * ldw; a[ii] = __builtin_nontemporal_load((const f32x4*)src); b[ii] = __builtin_nontemporal_load((const f32x4*)(src + ldw)); } }
#pragma unroll
        for (int ii = 0; ii < NB; ++ii) { const int kp = 4 * (NB * hh + ii) + kq; LAS unsigned* d = scr + kp * 65 + cq;
            d[0] = pk2(a[ii][0], b[ii][0]); d[1] = pk2(a[ii][1], b[ii][1]); d[2] = pk2(a[ii][2], b[ii][2]); d[3] = pk2(a[ii][3], b[ii][3]); }
    }
    LDS_WAIT();
    const int c = lane & 7;
#pragma unroll
    for (int j = 0; j < 8; ++j) { const int n = (lane >> 3) + 8 * j; const LAS unsigned* sp = scr + (4 * c) * 65 + n;
        u32x4 o; o.x = sp[0]; o.y = sp[65]; o.z = sp[130]; o.w = sp[195];
        if constexpr (NTS) __builtin_nontemporal_store(o, (u32x4*)(WT + (size_t)(drow0 + n) * K + k0 + 8 * c)); else *(u32x4*)(WT + (size_t)(drow0 + n) * K + k0 + 8 * c) = o; }
    LDS_WAIT();
}
__device__ __forceinline__ void ln_norm(const float* g, const float* b, int lane, f32x4 (&v)[8]) {
    float s = 0.f;
#pragma unroll
    for (int j = 0; j < 8; ++j) s += (v[j][0] + v[j][1]) + (v[j][2] + v[j][3]);
    const float mean = wave_sum(s) * (1.f / D); float s2 = 0.f;
#pragma unroll
    for (int j = 0; j < 8; ++j) { v[j] = v[j] - mean; s2 += (v[j][0] * v[j][0] + v[j][1] * v[j][1]) + (v[j][2] * v[j][2] + v[j][3] * v[j][3]); }
    const float rstd = 1.f / sqrtf(wave_sum(s2) * (1.f / D) + LN_EPS);
#pragma unroll
    for (int j = 0; j < 8; ++j) { const f32x4 gg = *(const f32x4*)(g + 4 * lane + 256 * j), bb = *(const f32x4*)(b + 4 * lane + 256 * j); v[j] = v[j] * rstd * gg + bb; }
}
__device__ __forceinline__ void ln_row(const bf16_t* xrow, const float* g, const float* b, int lane, f32x4 (&v)[8]) {
#pragma unroll
    for (int j = 0; j < 8; ++j) { const u32x2 w = __builtin_nontemporal_load((const u32x2*)(xrow + 4 * lane + 256 * j)); v[j] = (f32x4){bflo(w.x), bfhi(w.x), bflo(w.y), bfhi(w.y)}; }
    ln_norm(g, b, lane, v);
}
__device__ __forceinline__ void ln_row_tail(const bf16_t* part, int nparts, int row, const bf16_t* res, const float* g, const float* b, int lane, f32x4 (&v)[8]) {
#pragma unroll
    for (int j = 0; j < 8; ++j) { const u32x2 rr = *(const u32x2*)(res + (size_t)row * D + 4 * lane + 256 * j);
        v[j] = (f32x4){ALPHA * bflo(rr.x), ALPHA * bfhi(rr.x), ALPHA * bflo(rr.y), ALPHA * bfhi(rr.y)}; }
    int pp = 0;
    for (; pp + 1 < nparts; pp += 2) { const bf16_t* pr = part + ((size_t)pp * 512 + (row - 8192)) * D + 4 * lane; const bf16_t* pr2 = pr + (size_t)512 * D;
        u32x2 a[8], b[8];
#pragma unroll
        for (int j = 0; j < 8; ++j) { a[j] = __builtin_nontemporal_load((const u32x2*)(pr + 256 * j)); b[j] = __builtin_nontemporal_load((const u32x2*)(pr2 + 256 * j)); }
#pragma unroll
        for (int j = 0; j < 8; ++j) v[j] += (f32x4){bflo(a[j].x) + bflo(b[j].x), bfhi(a[j].x) + bfhi(b[j].x), bflo(a[j].y) + bflo(b[j].y), bfhi(a[j].y) + bfhi(b[j].y)}; }
    if (pp < nparts) { const bf16_t* pr = part + ((size_t)pp * 512 + (row - 8192)) * D + 4 * lane;
#pragma unroll
        for (int j = 0; j < 8; ++j) { const u32x2 a = *(const u32x2*)(pr + 256 * j); v[j] += (f32x4){bflo(a.x), bfhi(a.x), bflo(a.y), bfhi(a.y)}; } }
    ln_norm(g, b, lane, v);
}
__device__ __forceinline__ void store_row_bf16(bf16_t* orow, int lane, const f32x4 (&v)[8]) {
#pragma unroll
    for (int j = 0; j < 8; ++j) { u32x2 o; o.x = pk2(v[j][0], v[j][1]); o.y = pk2(v[j][2], v[j][3]); *(u32x2*)(orow + 4 * lane + 256 * j) = o; }
}

template <int NB> __device__ __forceinline__ void transposes(const Params& p, LAS unsigned char* lds, int it_lo, int it_hi, int gw, int NGW, int w, int lane) {
    LAS unsigned* scr = (LAS unsigned*)(lds + w * 8448);
    bf16_t* Bt1 = (bf16_t*)(p.ws + WS_BT1); bf16_t* Bt2 = (bf16_t*)(p.ws + WS_BT2); bf16_t* Bt3 = (bf16_t*)(p.ws + WS_BT3); bf16_t* Bt4 = (bf16_t*)(p.ws + WS_BT4);
    constexpr int NB1 = N1 / 64, NB2 = D / 64, NB3 = N3 / 64, NB4 = D / 64;
    constexpr int I1 = 32 * NB1, I2 = 32 * NB2, I3 = 32 * NB3;
    for (int it = it_lo + gw; it < it_hi; it += NGW) {
        int r = it;
        if (r < I1) { const int kb = r / NB1, n0 = (r % NB1) * 64; int src, nv;
            if (n0 < 4096) { src = n0; nv = 64; }
            else if (n0 < 16384) {
                const int grp = (n0 - 4096) >> 12, rel = (n0 - 4096) & 4095, hf = (rel >> 7) & 1;
                const int base = grp == 0 ? (hf ? 12304 : 4096) : (grp == 1 ? (hf ? 10256 : 8208) : (hf ? 14352 : 6160));
                src = base + (rel >> 8) * 128 + (rel & 127); nv = 64; }
            else if (n0 == 16384) { src = 6144; nv = 16; } else { src = 0; nv = 0; }
            tr_item<NB>(p.in[7], 16400, kb * 64, src, nv, Bt1, D, n0, scr, lane); continue; }
        r -= I1;
        if (r < I2) { const int kb = r / NB2, n0 = (r % NB2) * 64; tr_item<NB, true>(p.in[12], D, kb * 64, n0, 64, Bt2, D, n0, scr, lane); continue; }
        r -= I2;
        if (r < I3) { const int kb = r / NB3, n0 = (r % NB3) * 64; const int src = ((n0 >> 7) & 1) * DFF + (n0 >> 8) * 128 + (n0 & 127);
            tr_item<NB, true>(p.in[15], N3, kb * 64, src, 64, Bt3, D, n0, scr, lane); continue; }
        r -= I3;
        { const int kb = r / NB4, n0 = (r % NB4) * 64; tr_item<NB, true>(p.in[16], D, kb * 64, n0, 64, Bt4, DFF, n0, scr, lane); }
    }
}
constexpr int TR_I1 = 32 * (N1 / 64), TR_ALL = TR_I1 + 32 * (D / 64) + 32 * (N3 / 64) + (DFF / 64) * (D / 64);
constexpr int TR_SPLIT = TR_ALL;
constexpr int TR_IDLE = 3760;
__device__ __forceinline__ void phase0(const Params& p, LAS unsigned char* lds) {
    const int tid_ = fresh_tid(); const int lane = tid_ & 63, w = tid_ >> 6;
    const int gw = blockIdx.x * 8 + w, NGW = gridDim.x * 8;
    bf16_t* XN = (bf16_t*)(p.ws + WS_XN);
    for (int row = gw; row < MP; row += NGW) {
        bf16_t* orow = XN + (size_t)row * D;
        if (row < ROW_META || row >= ROW_END) {
#pragma unroll
            for (int j = 0; j < 8; ++j) *(u32x2*)(orow + 4 * lane + 256 * j) = (u32x2){0u, 0u};
            continue;
        }
        const float* xr = row < ROW_PROMPT ? p.in[4] + (size_t)(row - ROW_META) * D : (row < ROW_SAMPLE ? p.in[0] + (size_t)(row - ROW_PROMPT) * D : p.in[1] + (size_t)(row - ROW_SAMPLE) * D);
        f32x4 v[8];
#pragma unroll
        for (int j = 0; j < 8; ++j) v[j] = __builtin_nontemporal_load((const f32x4*)(xr + 4 * lane + 256 * j));
        ln_norm(p.in[5], p.in[6], lane, v); store_row_bf16(orow, lane, v);
    }
    transposes<8>(p, lds, 0, TR_ALL - TR_IDLE, gw, NGW, w, lane);
}

__device__ __forceinline__ float logsigmoid(float z) { return fminf(z, 0.f) - __logf(1.f + __expf(-fabsf(z))); }
__device__ __forceinline__ void gla_prep_item(const Params& p, LAS unsigned char* lds, int it) {
    const int tid = threadIdx.x, lane = tid & 63, w = tid >> 6, l15 = lane & 15, quad = lane >> 4;
    const int slot = it >> 2, h = it & 3;
    const int row0 = slot == 0 ? ROW_META : (slot < 129 ? slot * 64 : ROW_SAMPLE + (slot - 129) * 16);
    const int ntok = (slot == 0 || slot >= 129) ? 16 : 64;
    const float* Abuf = (const float*)(p.ws + WS_A);
    const bf16_t* Uqkv = (const bf16_t*)(p.ws + WS_UQKV);
    bf16_t* QT = (bf16_t*)(p.ws + WS_QT); bf16_t* KD = (bf16_t*)(p.ws + WS_KD); bf16_t* PM = (bf16_t*)(p.ws + WS_PM); float* DL = (float*)(p.ws + WS_DL); bf16_t* VT = (bf16_t*)(p.ws + WS_VT);
    LAS float* sA = (LAS float*)lds;
    LAS float* sTot = (LAS float*)(lds + 4096);
    LAS unsigned char* sQ = lds + 8192;
    LAS unsigned char* sK = lds + 8192 + 33792;
    if (tid < 256) { const int tok = tid >> 2, c4 = (tid & 3) * 4; f32x4 v = {0.f, 0.f, 0.f, 0.f};
        if (tok < ntok) v = *(const f32x4*)(Abuf + (size_t)(row0 + tok) * 16 + c4);
        *(LAS f32x4*)(sA + tok * 16 + c4) = v; }
#pragma unroll
    for (int j = 0; j < 8; ++j) { const int c = tid + 512 * j, isk = c >> 11, tok = (c >> 5) & 63, cc = c & 31;
        u32x4 v = {0u, 0u, 0u, 0u};
        if (tok < ntok) v = __builtin_nontemporal_load((const u32x4*)(Uqkv + (size_t)(row0 + tok) * 4096 + isk * 1024 + h * 256 + cc * 8));
        *(LAS u32x4*)((isk ? sK : sQ) + tok * 528 + cc * 16) = v; }
    __syncthreads();
    const int d = tid & 255, half = tid >> 8;
    float wg[16];
#pragma unroll
    for (int r = 0; r < 16; ++r) wg[r] = p.in[8][r * 1024 + h * 256 + d];
    const float bg = p.in[9][h * 256 + d];
    float bb[32]; float run = 0.f;
#pragma unroll
    for (int i = 0; i < 32; ++i) { const int tok = half * 32 + i;
        const f32x4 a0 = *(const LAS f32x4*)(sA + tok * 16), a1 = *(const LAS f32x4*)(sA + tok * 16 + 4), a2 = *(const LAS f32x4*)(sA + tok * 16 + 8), a3 = *(const LAS f32x4*)(sA + tok * 16 + 12);
        float z = bg;
        z += a0[0] * wg[0] + a0[1] * wg[1] + a0[2] * wg[2] + a0[3] * wg[3];
        z += a1[0] * wg[4] + a1[1] * wg[5] + a1[2] * wg[6] + a1[3] * wg[7];
        z += a2[0] * wg[8] + a2[1] * wg[9] + a2[2] * wg[10] + a2[3] * wg[11];
        z += a3[0] * wg[12] + a3[1] * wg[13] + a3[2] * wg[14] + a3[3] * wg[15];
        float g = logsigmoid(z) * (1.f / 16.f);
        if (tok >= ntok) g = 0.f;
        run += g; bb[i] = run; }
    sTot[half * 256 + d] = run;
    __syncthreads();
    const float t0 = sTot[d], t1 = sTot[256 + d];
    const float off = half ? t0 : 0.f, blast = t0 + t1;
    if (half == 0) DL[(size_t)it * 256 + d] = __expf(blast);
    const int dl5 = d & 31;
    const int pos = (d & ~31) + ((dl5 < 16) ? ((dl5 >> 2) * 8 + (dl5 & 3)) : (((dl5 - 16) >> 2) * 8 + 4 + (dl5 & 3)));
    unsigned kdp[16];
    const float eblast = __expf(blast);
#pragma unroll
    for (int i = 0; i < 32; i += 2) { const int tok = half * 32 + i;
        const float q0 = bf2f(*(const LAS bf16_t*)(sQ + tok * 528 + d * 2)), q1 = bf2f(*(const LAS bf16_t*)(sQ + (tok + 1) * 528 + d * 2));
        const float k0 = bf2f(*(const LAS bf16_t*)(sK + tok * 528 + d * 2)), k1 = bf2f(*(const LAS bf16_t*)(sK + (tok + 1) * 528 + d * 2));
        const float e0 = __expf(off + bb[i]), e1 = __expf(off + bb[i + 1]);
        const float r0 = __builtin_amdgcn_rcpf(e0), r1 = __builtin_amdgcn_rcpf(e1);
        const float kt0 = k0 * r0, kt1 = k1 * r1;
        const unsigned qq = pk2(q0 * 0.0625f * e0, q1 * 0.0625f * e1);
        const unsigned kk = pk2(kt0, kt1);
        asm volatile("s_waitcnt lgkmcnt(0)" ::: "memory");
        *(LAS bf16_t*)(sQ + tok * 528 + pos * 2) = (bf16_t)(qq & 0xffffu); *(LAS bf16_t*)(sQ + (tok + 1) * 528 + pos * 2) = (bf16_t)(qq >> 16);
        *(LAS bf16_t*)(sK + tok * 528 + pos * 2) = (bf16_t)(kk & 0xffffu); *(LAS bf16_t*)(sK + (tok + 1) * 528 + pos * 2) = (bf16_t)(kk >> 16);
        kdp[i >> 1] = pk2(kt0 * eblast, kt1 * eblast); }
    {
      bf16_t* kr = KD + (size_t)it * 16384 + (size_t)((((d >> 5) * 2 + ((d >> 4) & 1)) * 2 + half) * 64 + (d & 15)) * 8;
#pragma unroll
      for (int j = 0; j < 4; ++j) *(u32x4*)(kr + j * 128) = (u32x4){kdp[4 * j], kdp[4 * j + 1], kdp[4 * j + 2], kdp[4 * j + 3]}; }
    __syncthreads();
#pragma unroll
    for (int j = 0; j < 4; ++j) { const int c = tid + 512 * j, ln = c & 63, tt = (c >> 6) & 3, ww = c >> 8;
        *(u32x4*)(QT + (size_t)it * 16384 + (size_t)c * 8) = *(const LAS u32x4*)(sQ + (tt * 16 + (ln & 15)) * 528 + (32 * ww + (ln >> 4) * 8) * 2); }
#pragma unroll
    for (int e = 0; e < 2; ++e) { const int id = 2 * w + e, ti = id >> 2, tj = id & 3;
        f32x4 acc = {0.f, 0.f, 0.f, 0.f};
        if (tj <= ti) {
#pragma unroll
            for (int ks = 0; ks < 8; ++ks) { const bf16x8 A = *(const LAS bf16x8*)(sK + (tj * 16 + l15) * 528 + ks * 64 + quad * 16), B = *(const LAS bf16x8*)(sQ + (ti * 16 + l15) * 528 + ks * 64 + quad * 16);
                acc = __builtin_amdgcn_mfma_f32_16x16x32_bf16(A, B, acc, 0, 0, 0); }
        }
        const int i = ti * 16 + l15, j0 = tj * 16 + quad * 4;
#pragma unroll
        for (int r = 0; r < 4; ++r) if (j0 + r > i) acc[r] = 0.f;
        *(u32x2*)(PM + (size_t)it * 4096 + (size_t)(((ti * 2 + (tj >> 1)) * 64 + ((tj & 1) * 2 + (quad >> 1)) * 16 + l15) * 8 + (quad & 1) * 4)) = (u32x2){pk2(acc[0], acc[1]), pk2(acc[2], acc[3])}; }
#pragma unroll
    for (int ps = 0; ps < 2; ++ps) { const int c = ps * 256 + d; unsigned vp[16];
#pragma unroll
        for (int i = 0; i < 32; i += 2) { const int tok = half * 32 + i; unsigned v0 = 0, v1 = 0;
            if (tok < ntok) { const bf16_t* ur = Uqkv + (size_t)(row0 + tok) * 4096 + 2048 + h * 512 + c; v0 = __builtin_nontemporal_load(ur); v1 = __builtin_nontemporal_load(ur + 4096); }
            vp[i >> 1] = v0 | (v1 << 16); }
        bf16_t* vr = VT + (size_t)it * 32768 + (size_t)(((c >> 4) * 2 + half) * 64 + (c & 15)) * 8;
#pragma unroll
        for (int j = 0; j < 4; ++j) *(u32x4*)(vr + j * 128) = (u32x4){vp[4 * j], vp[4 * j + 1], vp[4 * j + 2], vp[4 * j + 3]}; }
    __syncthreads();
}

struct ScanOps { bf16x8 q[4]; bf16x8 kd[2][2]; bf16x8 v[2]; bf16x8 pp[2]; f32x4 dl[2]; };
__device__ __forceinline__ void scan_load(const Params& p, ScanOps& o, int it, int kw, int vt16, int khalf, int kq, int l15, int quad) {
    const bf16_t* QT = (const bf16_t*)(p.ws + WS_QT); const bf16_t* KD = (const bf16_t*)(p.ws + WS_KD); const bf16_t* PM = (const bf16_t*)(p.ws + WS_PM);
    const float* DL = (const float*)(p.ws + WS_DL); const bf16_t* VT = (const bf16_t*)(p.ws + WS_VT);
    const int lane = quad * 16 + l15;
#pragma unroll
    for (int tt = 0; tt < 4; ++tt) o.q[tt] = *(const bf16x8*)(QT + (size_t)it * 16384 + (size_t)((kw * 4 + tt) * 64 + lane) * 8);
#pragma unroll
    for (int t = 0; t < 2; ++t)
#pragma unroll
        for (int ks = 0; ks < 2; ++ks) o.kd[t][ks] = *(const bf16x8*)(KD + (size_t)it * 16384 + (size_t)(((kw * 2 + t) * 2 + ks) * 64 + lane) * 8);
#pragma unroll
    for (int ks = 0; ks < 2; ++ks) o.v[ks] = *(const bf16x8*)(VT + (size_t)it * 32768 + (size_t)((vt16 * 2 + ks) * 64 + lane) * 8);
    const bf16_t* pbase = khalf == 0 ? PM + (size_t)it * 4096 + (size_t)(kq * 2 * 64) * 8 : (const bf16_t*)(p.ws + WS_ZERO) - (size_t)0;
#pragma unroll
    for (int ks = 0; ks < 2; ++ks) o.pp[ks] = *(const bf16x8*)(pbase + (khalf == 0 ? (size_t)(ks * 64 + lane) * 8 : (size_t)(lane & 31) * 8));
#pragma unroll
    for (int t = 0; t < 2; ++t) o.dl[t] = *(const f32x4*)(DL + (size_t)it * 256 + 32 * kw + 16 * t + quad * 4);
}
__device__ __forceinline__ void gla_step(LAS float* red, const ScanOps& cur, f32x4 (&S)[2], int kq, int lane, int& step) {
    const int buf = step & 1; ++step;
    u32x4 sp; sp.x = pk2(S[0][0], S[0][1]); sp.y = pk2(S[0][2], S[0][3]); sp.z = pk2(S[1][0], S[1][1]); sp.w = pk2(S[1][2], S[1][3]);
    const bf16x8 Sb = __builtin_bit_cast(bf16x8, sp);
    f32x4 ao[4];
#pragma unroll
    for (int tt = 0; tt < 4; ++tt) ao[tt] = __builtin_amdgcn_mfma_f32_16x16x32_bf16(cur.q[tt], Sb, (f32x4){0.f, 0.f, 0.f, 0.f}, 0, 0, 0);
    f32x4 ai = {0.f, 0.f, 0.f, 0.f};
#pragma unroll
    for (int ks = 0; ks < 2; ++ks) ai = __builtin_amdgcn_mfma_f32_16x16x32_bf16(cur.pp[ks], cur.v[ks], ai, 0, 0, 0);
    LAS float* rw = red + (buf * 6 + kq) * 1024 + lane * 4;
#pragma unroll
    for (int tt = 0; tt < 4; ++tt) *(LAS f32x4*)(rw + tt * 256) = ao[tt];
    *(LAS f32x4*)(red + (buf * 6 + 4) * 1024 + (kq * 64 + lane) * 4) = ai;
    asm volatile("s_waitcnt lgkmcnt(0)" ::: "memory"); __builtin_amdgcn_s_barrier(); asm volatile("" ::: "memory");
#pragma unroll
    for (int t = 0; t < 2; ++t) { f32x4 u = {0.f, 0.f, 0.f, 0.f};
#pragma unroll
        for (int ks = 0; ks < 2; ++ks) u = __builtin_amdgcn_mfma_f32_16x16x32_bf16(cur.kd[t][ks], cur.v[ks], u, 0, 0, 0);
        S[t] = cur.dl[t] * S[t] + u; }
}
__device__ __forceinline__ void gla_consume(const Params& p, LAS float* red, int c, int slot, int h, int khalf, int vs16, int& step) {
    const int buf = step & 1; ++step;
    asm volatile("" ::: "memory"); __builtin_amdgcn_s_barrier(); asm volatile("" ::: "memory");
    bf16_t* O = (bf16_t*)(p.ws + WS_O) + (size_t)khalf * MP * D;
    f32x4 sum = *(const LAS f32x4*)(red + (buf * 6 + 4) * 1024 + c * 4);
#pragma unroll
    for (int k4 = 0; k4 < 4; ++k4) sum += *(const LAS f32x4*)(red + (buf * 6 + k4) * 1024 + c * 4);
    const int tt = c >> 6, ln = c & 63, tok0 = 16 * tt + (ln >> 4) * 4;
    const int ntok = (slot == 0 || slot >= 129) ? 16 : 64, row0 = slot == 0 ? ROW_META : (slot < 129 ? slot * 64 : ROW_SAMPLE + (slot - 129) * 16);
    const int rowb = tok0 < ntok ? row0 + tok0 : ROW_END + tok0;
    bf16_t* op = O + (size_t)rowb * D + h * 512 + vs16 * 16 + (ln & 15);
    const unsigned w01 = pk2(sum[0], sum[1]), w23 = pk2(sum[2], sum[3]);
    op[0] = (bf16_t)(w01 & 0xffffu); op[D] = (bf16_t)(w01 >> 16); op[2 * D] = (bf16_t)(w23 & 0xffffu); op[3 * D] = (bf16_t)(w23 >> 16);
}
__device__ __forceinline__ void gla_chain(const Params& p, LAS unsigned char* lds, int slot0, int nslots, int h, int khalf, int vs16, float* Sout, int& step) {
    const int tid = fresh_tid(), lane = tid & 63, w = __builtin_amdgcn_readfirstlane(tid >> 6), l15 = lane & 15, quad = lane >> 4;
    LAS float* red = (LAS float*)lds;
    if (w >= 4) { for (int s = 0; s < nslots; ++s) gla_consume(p, red, tid - 256, slot0 + s, h, khalf, vs16, step); return; }
    const int kq = w, kw = khalf * 4 + kq;
    f32x4 S[2];
#pragma unroll
    for (int t = 0; t < 2; ++t) S[t] = (f32x4){0.f, 0.f, 0.f, 0.f};
    const int last = slot0 + nslots - 1;
    ScanOps A, B;
    scan_load(p, A, slot0 * 4 + h, kw, vs16, khalf, kq, l15, quad);
    int s = 0;
    for (; s + 1 < nslots; s += 2) {
        scan_load(p, B, (slot0 + s + 1) * 4 + h, kw, vs16, khalf, kq, l15, quad);
        gla_step(red, A, S, kq, lane, step);
        { const int sn = slot0 + s + 2 < last ? slot0 + s + 2 : last; scan_load(p, A, sn * 4 + h, kw, vs16, khalf, kq, l15, quad); }
        gla_step(red, B, S, kq, lane, step);
    }
    if (s < nslots) gla_step(red, A, S, kq, lane, step);
#pragma unroll
    for (int t = 0; t < 2; ++t)
#pragma unroll
        for (int r = 0; r < 4; ++r) Sout[(size_t)(32 * kw + 16 * t + quad * 4 + r) * 512 + vs16 * 16 + l15] = S[t][r];
}

struct SampItem { int slot, h, khalf, vs16, sh; };
__device__ __forceinline__ SampItem samp_decode(int i2) { SampItem m; m.sh = i2 >> 6; m.slot = 129 + (m.sh >> 2); m.h = m.sh & 3; m.khalf = (i2 >> 5) & 1; m.vs16 = i2 & 31; return m; }
__device__ __forceinline__ void samp_load(const Params& p, const SampItem& m, ScanOps& o, f32x4 (&S)[2], int kq, int l15, int quad) {
    const int kw = m.khalf * 4 + kq;
    scan_load(p, o, m.slot * 4 + m.h, kw, m.vs16, m.khalf, kq, l15, quad);
    const float* S0 = p.in[2] + (size_t)m.sh * 256 * 512 + (size_t)(32 * kw + quad * 4) * 512 + m.vs16 * 16 + l15;
#pragma unroll
    for (int t = 0; t < 2; ++t)
#pragma unroll
        for (int r = 0; r < 4; ++r) S[t][r] = __builtin_nontemporal_load(S0 + (size_t)(16 * t + r) * 512);
}
__device__ __forceinline__ void samp_store(const Params& p, const SampItem& m, const f32x4 (&S)[2], int kq, int l15, int quad) {
    const int kw = m.khalf * 4 + kq;
    float* So = p.out + OUT_SS + (size_t)m.sh * 256 * 512 + (size_t)(32 * kw + quad * 4) * 512 + m.vs16 * 16 + l15;
#pragma unroll
    for (int t = 0; t < 2; ++t)
#pragma unroll
        for (int r = 0; r < 4; ++r) __builtin_nontemporal_store(S[t][r], So + (size_t)(16 * t + r) * 512);
}
__device__ __forceinline__ void gla_samples(const Params& p, LAS unsigned char* lds, int i2_first, int stride, int n, int& step) {
    const int tid = fresh_tid(), lane = tid & 63, w = __builtin_amdgcn_readfirstlane(tid >> 6), l15 = lane & 15, quad = lane >> 4;
    LAS float* red = (LAS float*)lds;
    if (w >= 4) { for (int j = 0; j < n; ++j) { const SampItem m = samp_decode(i2_first + j * stride); gla_consume(p, red, tid - 256, m.slot, m.h, m.khalf, m.vs16, step); } return; }
    const int kq = w;
    SampItem ma = samp_decode(i2_first), mb = ma; ScanOps A, B; f32x4 SA[2], SB[2];
    samp_load(p, ma, A, SA, kq, l15, quad);
    int j = 0;
    for (; j + 1 < n; j += 2) {
        mb = samp_decode(i2_first + (j + 1) * stride); samp_load(p, mb, B, SB, kq, l15, quad);
        gla_step(red, A, SA, kq, lane, step); samp_store(p, ma, SA, kq, l15, quad);
        ma = samp_decode(i2_first + (j + 2 < n ? j + 2 : n - 1) * stride); samp_load(p, ma, A, SA, kq, l15, quad);
        gla_step(red, B, SB, kq, lane, step); samp_store(p, mb, SB, kq, l15, quad);
    }
    if (j < n) { gla_step(red, A, SA, kq, lane, step); samp_store(p, ma, SA, kq, l15, quad); }
}

__device__ __forceinline__ void unpack8(const u32x4 w, float (&f)[8]) { f[0] = bflo(w.x); f[1] = bfhi(w.x); f[2] = bflo(w.y); f[3] = bfhi(w.y); f[4] = bflo(w.z); f[5] = bfhi(w.z); f[6] = bflo(w.w); f[7] = bfhi(w.w); }
__device__ __forceinline__ float sigmoidf_(float x) { return __builtin_amdgcn_rcpf(1.f + __expf(-x)); }
__device__ __forceinline__ void conv_prev(const Params& p, int t, int k, int col, float (&out)[8]) {
    const bf16_t* Ur = (const bf16_t*)(p.ws + WS_UREST);
    const bool samp = t >= ROW_SAMPLE && t < ROW_END; const int si = (t - ROW_SAMPLE) & 15, stream = (t - ROW_SAMPLE) >> 4;
    if (samp && si < k) { const float* c = p.in[3] + ((size_t)stream * 2 + (si - k + 2)) * D + col;
        const f32x4 a = *(const f32x4*)c, b = *(const f32x4*)(c + 4);
#pragma unroll
        for (int j = 0; j < 4; ++j) { out[j] = a[j]; out[4 + j] = b[j]; }
    } else if (t - k >= 0) { unpack8(*(const u32x4*)(Ur + (size_t)(t - k) * 6144 + 2048 + col), out);
    } else {
#pragma unroll
        for (int j = 0; j < 8; ++j) out[j] = 0.f;
    }
}
struct MixIn { u32x4 o, o1, g1, g2, pc; };
__device__ __forceinline__ void mix_load(const Params& p, MixIn& m, int row, int col) {
    const bf16_t* ur = (const bf16_t*)(p.ws + WS_UREST) + (size_t)row * 6144 + col;
    m.o = __builtin_nontemporal_load((const u32x4*)((const bf16_t*)(p.ws + WS_O) + (size_t)row * D + col)); m.o1 = __builtin_nontemporal_load((const u32x4*)((const bf16_t*)(p.ws + WS_O) + (size_t)MP * D + (size_t)row * D + col));
    m.g1 = __builtin_nontemporal_load((const u32x4*)(ur)); m.pc = __builtin_nontemporal_load((const u32x4*)(ur + 2048)); m.g2 = __builtin_nontemporal_load((const u32x4*)(ur + 4096));
}
__device__ __forceinline__ void phase_mix(const Params& p) {
    const int tid_ = fresh_tid(); const int lane = tid_ & 63, w = tid_ >> 6, g = w & 3, half = w >> 2;
    const int col = g * 512 + lane * 8;
    bf16_t* Mb = (bf16_t*)(p.ws + WS_M);
    float gn[8], w0[8], w1[8], w2[8];
    { const float* gp = p.in[10] + col; const float* cp = p.in[11] + col;
#pragma unroll
      for (int j = 0; j < 8; ++j) { gn[j] = gp[j]; w0[j] = cp[j]; w1[j] = cp[D + j]; w2[j] = cp[2 * D + j]; } }
    const int rbeg = blockIdx.x * 34 + half * 17, rend = rbeg + 17;
    float p1[8], p2[8];
    conv_prev(p, rbeg, 1, col, p1); conv_prev(p, rbeg, 2, col, p2);
    MixIn cur; mix_load(p, cur, rbeg, col);
#pragma unroll 1
    for (int row = rbeg; row < rend; ++row) {
        MixIn nx; mix_load(p, nx, row + 1 < rend ? row + 1 : row, col);
        const bool samp = row >= ROW_SAMPLE && row < ROW_END; const int si = (row - ROW_SAMPLE) & 15, stream = (row - ROW_SAMPLE) >> 4;
        if (samp && si == 0) { conv_prev(p, row, 1, col, p1); conv_prev(p, row, 2, col, p2); }
        float o[8], g1[8], g2[8];
        { float ob[8]; unpack8(cur.o, o); unpack8(cur.o1, ob);
#pragma unroll
          for (int j = 0; j < 8; ++j) o[j] += ob[j]; }
        unpack8(cur.g1, g1); unpack8(cur.g2, g2);
        float ss = 0.f;
#pragma unroll
        for (int j = 0; j < 8; ++j) ss += o[j] * o[j];
        const float rs = 1.f / sqrtf(wave_sum(ss) * (1.f / 512.f) + RMS_EPS);
        const bool valid = row >= ROW_META && row < ROW_END;
        float mm[8], p0[8]; unpack8(cur.pc, p0);
#pragma unroll
        for (int j = 0; j < 8; ++j) {
            const float ya = o[j] * rs * gn[j] * g1[j];
            const float cv = w0[j] * p2[j] + w1[j] * p1[j] + w2[j] * p0[j];
            mm[j] = valid ? ya + g2[j] * cv : 0.f;
        }
        *(u32x4*)(Mb + (size_t)row * D + col) = (u32x4){pk2(mm[0], mm[1]), pk2(mm[2], mm[3]), pk2(mm[4], mm[5]), pk2(mm[6], mm[7])};
        float* co = nullptr;
        if (row == ROW_SAMPLE - 2) co = p.out + OUT_CP; else if (row == ROW_SAMPLE - 1) co = p.out + OUT_CP + D;
        else if (samp && si == 14) co = p.out + OUT_CS + ((size_t)stream * 2 + 0) * D; else if (samp && si == 15) co = p.out + OUT_CS + ((size_t)stream * 2 + 1) * D;
        if (co) { *(f32x4*)(co + col) = (f32x4){p0[0], p0[1], p0[2], p0[3]}; *(f32x4*)(co + col + 4) = (f32x4){p0[4], p0[5], p0[6], p0[7]}; }
#pragma unroll
        for (int j = 0; j < 8; ++j) { p2[j] = p1[j]; p1[j] = p0[j]; }
        cur = nx;
    }
}

__device__ __forceinline__ void phase_ln1(const Params& p) {
    const int tid_ = fresh_tid(); const int lane = tid_ & 63, w = tid_ >> 6; const int gw = blockIdx.x * 8 + w, NGW = gridDim.x * 8;
    const bf16_t* T = (const bf16_t*)(p.ws + WS_T1); bf16_t* H = (bf16_t*)(p.ws + WS_H);
    const bf16_t* Part = (const bf16_t*)(p.ws + WS_PART); const bf16_t* XN = (const bf16_t*)(p.ws + WS_XN);
    for (int row = gw; row < MP; row += NGW) { f32x4 v[8];
        if (row < 8192) ln_row(T + (size_t)row * D, p.in[13], p.in[14], lane, v); else ln_row_tail(Part, 8, row, XN, p.in[13], p.in[14], lane, v);
        store_row_bf16(H + (size_t)row * D, lane, v); }
}
__device__ __forceinline__ void phase_ln2(const Params& p) {
    const int tid_ = fresh_tid(); const int lane = tid_ & 63, w = tid_ >> 6; const int gw = blockIdx.x * 8 + w, NGW = gridDim.x * 8;
    const bf16_t* T = (const bf16_t*)(p.ws + WS_T2);
    const bf16_t* Part = (const bf16_t*)(p.ws + WS_PART); const bf16_t* H = (const bf16_t*)(p.ws + WS_H);
    for (int row = ROW_PROMPT + gw; row < ROW_END; row += NGW) { f32x4 v[8];
        if (row < 8192) ln_row(T + (size_t)row * D, p.in[17], p.in[18], lane, v); else ln_row_tail(Part, 11, row, H, p.in[17], p.in[18], lane, v);
        float* orow = row < ROW_SAMPLE ? p.out + OUT_YP + (size_t)(row - ROW_PROMPT) * D : p.out + OUT_YS + (size_t)(row - ROW_SAMPLE) * D;
#pragma unroll
        for (int j = 0; j < 8; ++j) __builtin_nontemporal_store(v[j], (f32x4*)(orow + 4 * lane + 256 * j)); }
}


#define XB_TMO      128
#define XB_XCNT(j)  (256  + 64 * (j))
#define XB_XSUB(j)  (1280 + 64 * (j))
#define XB_XGEN(j)  (2304 + 64 * (j))
#define XB_TOP      3328
#define XB_TOPGEN   3392
#define XCD_BAR_WORDS 3456
#define XB_SPIN_CAP (1u << 18)
__device__ __forceinline__ unsigned xb_ld(unsigned* p)              { return __hip_atomic_load(p, __ATOMIC_RELAXED, __HIP_MEMORY_SCOPE_AGENT); }
__device__ __forceinline__ unsigned xb_add(unsigned* p, unsigned v) { return __hip_atomic_fetch_add(p, v, __ATOMIC_RELAXED, __HIP_MEMORY_SCOPE_AGENT); }
__device__ __forceinline__ unsigned xb_xcc_id() { return (unsigned)__builtin_amdgcn_s_getreg((3 << 11) | 20) & 0xFu; }
#define XB_SPIN(cond, bar) do { unsigned _sp = 0; while (cond) { __builtin_amdgcn_s_sleep(1); \
    if ((++_sp & 255u) == 0u) { if (xb_ld(&(bar)[XB_TMO])) break; if (_sp > XB_SPIN_CAP) { atomicAdd(&(bar)[XB_TMO], 1u); break; } } } } while (0)
struct XcdBarrier { unsigned* bar; unsigned x; volatile LAS unsigned* st; };
__device__ __forceinline__ XcdBarrier xcd_barrier_post(unsigned* bar, volatile LAS unsigned* st) {
    XcdBarrier b; b.bar = bar; b.x = xb_xcc_id(); b.st = st;
    if (threadIdx.x == 0) (void)xb_add(&bar[XB_XCNT(b.x)], 1u);
    return b;
}
__device__ __forceinline__ void xcd_barrier_complete(unsigned* bar, unsigned x, unsigned& nloc, unsigned& nx) {
    const unsigned G = gridDim.x * gridDim.y * gridDim.z;
    unsigned sum, cnt, mine, sp = 0u;
    for (;;) {
        sum = 0u; cnt = 0u; mine = 0u;
#pragma unroll
        for (unsigned j = 0; j < 16; ++j) { const unsigned c = xb_ld(&bar[XB_XCNT(j)]); sum += c; cnt += (c > 0u) ? 1u : 0u; mine = (j == x) ? c : mine; }
        if (sum == G) break;
        __builtin_amdgcn_s_sleep(1);
        if ((++sp & 255u) == 0u) { if (xb_ld(&bar[XB_TMO])) break; if (sp > XB_SPIN_CAP) { atomicAdd(&bar[XB_TMO], 1u); break; } }
    }
    nloc = mine > 0u ? mine : 1u; nx = cnt > 0u ? cnt : 1u;
}
__device__ __forceinline__ void xcd_barrier(const XcdBarrier& b) {
    asm volatile("s_waitcnt vmcnt(0)" ::: "memory");
    __syncthreads();
    if (threadIdx.x == 0) {
        unsigned* bar = b.bar;
        __builtin_amdgcn_s_waitcnt(0);
        unsigned nloc = b.st[0], nx = b.st[1];
        if (nloc == 0u) { xcd_barrier_complete(bar, b.x, nloc, nx); b.st[0] = nloc; b.st[1] = nx; }
        const unsigned old = xb_add(&bar[XB_XSUB(b.x)], 1u);
        const unsigned gen = old / nloc;
        if (old + 1u == (gen + 1u) * nloc) {
            __builtin_amdgcn_fence(__ATOMIC_RELEASE, "agent");
            asm volatile("s_waitcnt vmcnt(0)" ::: "memory");
            const unsigned og = xb_add(&bar[XB_TOP], 1u);
            const unsigned tg = og / nx;
            if (og + 1u == (tg + 1u) * nx) xb_add(&bar[XB_TOPGEN], 1u);
            else XB_SPIN(xb_ld(&bar[XB_TOPGEN]) == tg, bar);
            __builtin_amdgcn_fence(__ATOMIC_ACQUIRE, "agent");
            xb_add(&bar[XB_XGEN(b.x)], 1u);
            asm volatile("s_waitcnt vmcnt(0)" ::: "memory");
        } else {
            XB_SPIN(xb_ld(&bar[XB_XGEN(b.x)]) == gen, bar);
            __builtin_amdgcn_fence(__ATOMIC_ACQUIRE, "agent");
            asm volatile("s_waitcnt vmcnt(0)" ::: "memory");
        }
    }
    __syncthreads();
}

#ifndef DUP
#define DUP 0
#ifndef DUPC
#define DUPC 0
#endif
#ifndef DUPS
#define DUPS 0
#endif
#endif
#define REP(bit) for (int _rep = 0; _rep < (((DUP) >> (bit)) & 1) + 1; ++_rep)
__global__ void __launch_bounds__(512, 2) fwd_megakernel(Params p) {
    extern __shared__ __attribute__((aligned(16))) unsigned char shm_raw[];
    LAS unsigned char* lds = (LAS unsigned char*)shm_raw;
    cg::grid_group grid = cg::this_grid();
    const int G = gridDim.x, bid = blockIdx.x;
    if (p.ws == nullptr) grid.sync();
    volatile LAS unsigned* xst = (volatile LAS unsigned*)(lds + pg8::STAGE_BYTES);
    if (threadIdx.x == 0) { xst[0] = 0u; xst[1] = 0u; }
    __syncthreads();
    const XcdBarrier xb = xcd_barrier_post((unsigned*)(p.ws + WS_BAR), xst);

    REP(0) { phase0(p, lds);
    xcd_barrier(xb); }
    REP(1) { pg8::Gemm g{(const bf16_t*)(p.ws + WS_XN), (const bf16_t*)(p.ws + WS_BT1), MP, N1, D};
      pg8::StaticOrder S; S.init(MP, N1, D, G, bid);
      EpiU E{(bf16_t*)(p.ws + WS_UQKV), (bf16_t*)(p.ws + WS_UREST), (float*)(p.ws + WS_A)};
      pg8::gemm_phase<EpiU, pg8::StaticOrder, true, true>(lds, g, S, E);
      if (bid >= 162) { const int tid_ = fresh_tid(); transposes<4>(p, lds, TR_ALL - TR_IDLE, TR_ALL, (bid - 162) * 8 + (tid_ >> 6), 94 * 8, tid_ >> 6, tid_ & 63); }
    xcd_barrier(xb); }
    REP(2) { for (int it = bid; it < NITEM; it += G) gla_prep_item(p, lds, it);
    xcd_barrier(xb); }
    REP(3) { int step = 0;
      gla_chain(p, lds, 0, 129, (bid & 7) >> 1, bid & 1, bid >> 3, p.out + OUT_SP + (size_t)((bid & 7) >> 1) * 256 * 512, step);
      __syncthreads();
      gla_samples(p, lds, ((bid & 7) >> 1) * 64 + (bid & 1) * 32 + (bid >> 3), 256, 16, step);
      if (G >= 256 && bid >= 128) {
          __syncthreads();
          const int tid_ = fresh_tid();
          transposes<4>(p, lds, TR_SPLIT, TR_ALL, (bid - 128) * 8 + (tid_ >> 6), (G - 128) * 8, tid_ >> 6, tid_ & 63);
      }
    xcd_barrier(xb); }
    REP(4) { phase_mix(p);
    xcd_barrier(xb); }
    REP(5) { pg8::Gemm g{(const bf16_t*)(p.ws + WS_M), (const bf16_t*)(p.ws + WS_BT2), MP, D, D};
      pg8::TailOrder S; S.init(D, bid, 8, 4);
      EpiRes E{(bf16_t*)(p.ws + WS_T1), (const bf16_t*)(p.ws + WS_XN), (bf16_t*)(p.ws + WS_PART)};
      pg8::gemm_phase<EpiRes, pg8::TailOrder, true, true>(lds, g, S, E);
    xcd_barrier(xb); }
    REP(6) { phase_ln1(p);
    xcd_barrier(xb); }
    REP(7) { pg8::Gemm g{(const bf16_t*)(p.ws + WS_H), (const bf16_t*)(p.ws + WS_BT3), MP, N3, D};
      pg8::StaticOrder S; S.init(MP, N3, D, G, bid);
      EpiSwiglu E{(bf16_t*)(p.ws + WS_ACT)};
      pg8::gemm_phase<EpiSwiglu, pg8::StaticOrder, true, true>(lds, g, S, E);
    xcd_barrier(xb); }
    REP(8) { pg8::Gemm g{(const bf16_t*)(p.ws + WS_ACT), (const bf16_t*)(p.ws + WS_BT4), MP, D, DFF};
      pg8::TailOrder S; S.init(DFF, bid, 11, 8);
      EpiRes E{(bf16_t*)(p.ws + WS_T2), (const bf16_t*)(p.ws + WS_H), (bf16_t*)(p.ws + WS_PART)};
      pg8::gemm_phase<EpiRes, pg8::TailOrder, true, true>(lds, g, S, E);
    xcd_barrier(xb); }
    REP(9) phase_ln2(p);
}

extern "C" void kernel_launch(void* const* d_in, const int* in_sizes, int n_in, void* d_out, int out_size, void* d_ws, size_t ws_size, hipStream_t stream) {
    constexpr size_t kDynLds = pg8::STAGE_BYTES + 16;
    static int grid_blocks = 0;
    if (!grid_blocks) {
        if (n_in != 19 || ws_size < WS_END) { fprintf(stderr, "kernel_launch: unexpected n_in %d / ws_size %zu (need %zu)\n", n_in, ws_size, (size_t)WS_END); grid_blocks = -1; return; }
        int dev = 0, cus = 0, per_cu = 0;
        hipGetDevice(&dev);
        hipDeviceGetAttribute(&cus, hipDeviceAttributeMultiprocessorCount, dev);
        hipFuncSetAttribute((const void*)fwd_megakernel, hipFuncAttributeMaxDynamicSharedMemorySize, (int)kDynLds);
        hipOccupancyMaxActiveBlocksPerMultiprocessor(&per_cu, (const void*)fwd_megakernel, 512, kDynLds);
        if (per_cu < 1) { fprintf(stderr, "kernel_launch: occupancy query says %d blocks/CU\n", per_cu); grid_blocks = -1; return; }
        if (cus != 256) { fprintf(stderr, "kernel_launch: built for 256 CUs, device has %d\n", cus); grid_blocks = -1; return; }
        grid_blocks = cus;
    }
    if (grid_blocks < 0) return;
    if (hipMemsetAsync((char*)d_ws + WS_BAR, 0, 16384, stream) != hipSuccess) { fprintf(stderr, "kernel_launch: memset of the barrier words failed\n"); return; }
    Params p{};
    for (int i = 0; i < 19; ++i) p.in[i] = (const float*)d_in[i];
    p.out = (float*)d_out; p.ws = (unsigned char*)d_ws;
    void* args[] = {&p};
    hipError_t e = hipLaunchCooperativeKernel((const void*)fwd_megakernel, dim3(grid_blocks), dim3(512), args, kDynLds, stream);
    if (e != hipSuccess) fprintf(stderr, "cooperative launch failed: %s (grid %d)\n", hipGetErrorString(e), grid_blocks);
}
```
